# Optimizing an MI355X kernel written in HIP

```python
import math
import jax, jax.numpy as jnp
from jax import lax
import numpy as np

D_MODEL = 1024
BATCH = 2
SEQ = 8192
DEPTH = 1

CHUNK = 64
N_META = 16
QBLK = 128
HEAD_DIM = 64
N_DIFF_HEADS = D_MODEL // 256
DIFF_V_DIM = 2 * HEAD_DIM
DIFF_QK = N_DIFF_HEADS * 2 * HEAD_DIM
DIFF_WIDTH = N_DIFF_HEADS * DIFF_V_DIM
N_SB_HEADS = D_MODEL // 128
SB_WIDTH = N_SB_HEADS * HEAD_DIM
MIX_WIDTH = DIFF_WIDTH + SB_WIDTH
PROJ_SIZES = (DIFF_QK, DIFF_QK, DIFF_WIDTH, SB_WIDTH, SB_WIDTH, SB_WIDTH)
PROJ_WIDTH = sum(PROJ_SIZES)
N_BUCKETS = 32
MAX_DIST = 128
N_GROUPS = 4
EXPERTS_PER_GROUP = 4
N_EXPERTS = N_GROUPS * EXPERTS_PER_GROUP
EXPERT_TOP_K = 2
D_EXPERT = D_MODEL // 2
EPS = 1e-6
NEG_INF = -1e30
BIG_CHUNK = 1 << 30

kernel_name = 'hybrid_diff_stickbreak_hmoe'


def rms_norm(x, g):
    xf = x.astype(jnp.float32)
    y = xf * lax.rsqrt(jnp.mean(xf * xf, axis=-1, keepdims=True) + EPS)
    return (y * g.astype(jnp.float32)).astype(x.dtype)


def chunk_ids(pos, length):
    real = (pos - N_META) // CHUNK + 1
    cid = jnp.where(pos < N_META, 0, real)
    return jnp.where(pos < length, cid, BIG_CHUNK)


def t5_bucket(rel):
    half = N_BUCKETS // 2
    max_exact = half // 2
    ret = jnp.where(rel > 0, half, 0)
    n = jnp.abs(rel)
    nf = jnp.maximum(n, 1).astype(jnp.float32)
    large = max_exact + (jnp.log(nf / max_exact) / math.log(MAX_DIST / max_exact)
                         * (half - max_exact)).astype(jnp.int32)
    large = jnp.minimum(large, half - 1)
    return ret + jnp.where(n < max_exact, n, large)


def to_blocks(t):
    b, h, lp, d = t.shape
    return t.reshape(b, h, lp // QBLK, QBLK, d).transpose(2, 0, 1, 3, 4)


def from_blocks(t):
    n, b, h, q, d = t.shape
    return t.transpose(1, 2, 0, 3, 4).reshape(b, h, n * q, d)


def diff_attention(q1, q2, k1, k2, v, lam, rel_table, length):
    lp = k1.shape[2]
    n_blk = lp // QBLK
    kpos = jnp.arange(lp)
    kchunk = chunk_ids(kpos, length)
    kvalid = kpos < length
    scale = HEAD_DIM ** -0.5
    table = rel_table.astype(jnp.float32)
    vf = v.astype(jnp.float32)

    def block(args):
        b, qb1, qb2 = args
        qpos = b * QBLK + jnp.arange(QBLK)
        mask = (kchunk[None, :] <= chunk_ids(qpos, length)[:, None]) & kvalid[None, :]
        bias = table[t5_bucket(kpos[None, :] - qpos[:, None])].transpose(2, 0, 1)[None]

        def probs(qb, k):
            s = jnp.einsum('bhqd,bhkd->bhqk', qb, k, preferred_element_type=jnp.float32) * scale + bias
            return jax.nn.softmax(jnp.where(mask, s, NEG_INF), axis=-1)

        w = probs(qb1, k1) - lam * probs(qb2, k2)
        return jnp.einsum('bhqk,bhkd->bhqd', w, vf)

    out = lax.map(block, (jnp.arange(n_blk), to_blocks(q1), to_blocks(q2)))
    return from_blocks(out)


def stick_breaking(q, k, v):
    lp = k.shape[2]
    n_blk = lp // QBLK
    kpos = jnp.arange(lp)
    scale = HEAD_DIM ** -0.5
    vf = v.astype(jnp.float32)

    def block(args):
        b, qb = args
        qpos = b * QBLK + jnp.arange(QBLK)
        mask = (kpos[None, :] < qpos[:, None])[None, None]
        z = jnp.einsum('bhqd,bhkd->bhqk', qb, k, preferred_element_type=jnp.float32) * scale
        log_keep = jnp.where(mask, jax.nn.log_sigmoid(-z), 0.0)
        log_a = jax.nn.log_sigmoid(z) + lax.cumsum(log_keep, axis=3, reverse=True) - log_keep
        a = jnp.where(mask, jnp.exp(log_a), 0.0)
        return jnp.einsum('bhqk,bhkd->bhqd', a, vf)

    out = lax.map(block, (jnp.arange(n_blk), to_blocks(q)))
    return from_blocks(out)


def hier_moe(x, w_group, w_router, w_gate, w_up, w_down):
    b, l, d = x.shape
    xf = x.reshape(-1, d)
    n = xf.shape[0]
    g_prob = jax.nn.softmax(jnp.matmul(xf, w_group).astype(jnp.float32), axis=-1)
    g_idx = jnp.argmax(g_prob, axis=-1)
    g_w = jnp.take_along_axis(g_prob, g_idx[:, None], axis=1)[:, 0]
    e_logit = jnp.matmul(xf, w_router).astype(jnp.float32).reshape(n, N_GROUPS, EXPERTS_PER_GROUP)
    e_logit = jnp.take_along_axis(e_logit, g_idx[:, None, None], axis=1)[:, 0]
    e_prob = jax.nn.softmax(e_logit, axis=-1)
    top_w, top_i = lax.top_k(e_prob, EXPERT_TOP_K)
    top_w = top_w / jnp.sum(top_w, axis=-1, keepdims=True)
    eid = g_idx[:, None] * EXPERTS_PER_GROUP + top_i
    comb = jnp.sum(jax.nn.one_hot(eid, N_EXPERTS, dtype=jnp.float32)
                   * (g_w[:, None] * top_w)[..., None], axis=1)
    y = jnp.zeros((n, d), jnp.float32)
    for e in range(N_EXPERTS):
        hdn = jax.nn.silu(jnp.matmul(xf, w_gate[e])) * jnp.matmul(xf, w_up[e])
        y = y + comb[:, e:e + 1] * jnp.matmul(hdn, w_down[e]).astype(jnp.float32)
    return y.astype(x.dtype).reshape(b, l, d)


def setup_inputs(seed: int = 0) -> dict:
    key = jax.random.key(seed)
    ks = jax.random.split(key, 20)
    f32 = jnp.float32
    nrm = lambda k, shape, s: jax.random.normal(k, shape, f32) * s
    return {
        'x': nrm(ks[0], (BATCH, SEQ, D_MODEL), 1.0),
        'meta_tokens': nrm(ks[1], (N_META, D_MODEL), 1.0),
        'rel_table': nrm(ks[2], (N_BUCKETS, N_DIFF_HEADS), 0.5),
        'attn_norm': 1.0 + nrm(ks[3], (DEPTH, D_MODEL), 0.02),
        'w_in': nrm(ks[4], (DEPTH, D_MODEL, PROJ_WIDTH), D_MODEL ** -0.5),
        'lambda_q1': nrm(ks[5], (DEPTH, HEAD_DIM), 0.1),
        'lambda_k1': nrm(ks[6], (DEPTH, HEAD_DIM), 0.1),
        'lambda_q2': nrm(ks[7], (DEPTH, HEAD_DIM), 0.1),
        'lambda_k2': nrm(ks[8], (DEPTH, HEAD_DIM), 0.1),
        'diff_norm': 1.0 + nrm(ks[9], (DEPTH, DIFF_V_DIM), 0.02),
        'sb_norm': 1.0 + nrm(ks[10], (DEPTH, HEAD_DIM), 0.02),
        'w_out': nrm(ks[11], (DEPTH, MIX_WIDTH, D_MODEL), MIX_WIDTH ** -0.5),
        'ffn_norm': 1.0 + nrm(ks[12], (DEPTH, D_MODEL), 0.02),
        'w_group': nrm(ks[13], (DEPTH, D_MODEL, N_GROUPS), D_MODEL ** -0.5),
        'w_router': nrm(ks[14], (DEPTH, D_MODEL, N_EXPERTS), D_MODEL ** -0.5),
        'w_gate': nrm(ks[15], (DEPTH, N_EXPERTS, D_MODEL, D_EXPERT), D_MODEL ** -0.5),
        'w_up': nrm(ks[16], (DEPTH, N_EXPERTS, D_MODEL, D_EXPERT), D_MODEL ** -0.5),
        'w_down': nrm(ks[17], (DEPTH, N_EXPERTS, D_EXPERT, D_MODEL), D_EXPERT ** -0.5),
        'final_norm': 1.0 + nrm(ks[18], (D_MODEL,), 0.02),
    }


def reference(x, meta_tokens, rel_table, attn_norm, w_in, lambda_q1, lambda_k1, lambda_q2, lambda_k2,
              diff_norm, sb_norm, w_out, ffn_norm, w_group, w_router, w_gate, w_up, w_down, final_norm):
    b = x.shape[0]
    meta = jnp.broadcast_to(meta_tokens.astype(x.dtype)[None], (b, N_META, D_MODEL))
    h = jnp.concatenate([meta, x], axis=1)
    length = h.shape[1]
    lp = ((length + QBLK - 1) // QBLK) * QBLK
    offsets = [0]
    for s in PROJ_SIZES:
        offsets.append(offsets[-1] + s)

    for l in range(DEPTH):
        hn = rms_norm(h, attn_norm[l])
        proj = jnp.matmul(hn, w_in[l])
        proj = jnp.pad(proj, ((0, 0), (0, lp - length), (0, 0)))
        dq, dk, dv, sq, sk, sv = [proj[..., offsets[i]:offsets[i + 1]] for i in range(len(PROJ_SIZES))]
        dq = dq.reshape(b, lp, N_DIFF_HEADS, 2, HEAD_DIM).transpose(0, 2, 3, 1, 4)
        dk = dk.reshape(b, lp, N_DIFF_HEADS, 2, HEAD_DIM).transpose(0, 2, 3, 1, 4)
        dv = dv.reshape(b, lp, N_DIFF_HEADS, DIFF_V_DIM).transpose(0, 2, 1, 3)
        lambda_init = 0.8 - 0.6 * math.exp(-0.3 * l)
        lam = (jnp.exp(jnp.sum(lambda_q1[l].astype(jnp.float32) * lambda_k1[l].astype(jnp.float32)))
               - jnp.exp(jnp.sum(lambda_q2[l].astype(jnp.float32) * lambda_k2[l].astype(jnp.float32)))
               + lambda_init)
        a_out = diff_attention(dq[:, :, 0], dq[:, :, 1], dk[:, :, 0], dk[:, :, 1], dv, lam, rel_table, length)
        a_out = rms_norm(a_out, diff_norm[l]) * (1.0 - lambda_init)
        heads = lambda t: t.reshape(b, lp, N_SB_HEADS, HEAD_DIM).transpose(0, 2, 1, 3)
        s_out = rms_norm(stick_breaking(heads(sq), heads(sk), heads(sv)), sb_norm[l])
        mixed = jnp.concatenate([a_out.transpose(0, 2, 1, 3).reshape(b, lp, DIFF_WIDTH),
                                 s_out.transpose(0, 2, 1, 3).reshape(b, lp, SB_WIDTH)], axis=-1)
        mixed = mixed[:, :length].astype(h.dtype)
        h = h + jnp.matmul(mixed, w_out[l])
        h = h + hier_moe(rms_norm(h, ffn_norm[l]), w_group[l], w_router[l], w_gate[l], w_up[l], w_down[l])

    return rms_norm(h, final_norm)[:, N_META:]
```

```cpp
#include <hip/hip_runtime.h>
#include <cstdio>
#include <cstdint>
namespace pg8 {
#define PG8_LAS __attribute__((address_space(3)))
typedef unsigned short bf16_t;
typedef short bf16x8 __attribute__((ext_vector_type(8)));
typedef float f32x4 __attribute__((ext_vector_type(4)));
typedef unsigned u32x4 __attribute__((ext_vector_type(4)));
constexpr int BM = 256, BK = 64, HALF = 128, HTB = HALF * BK * 2  , STAGE_BYTES = 8 * HTB, NXCD = 8, WGM = 8;

__host__ __device__ __forceinline__ int lds_byte(int r, int c) { const int st = (r >> 4) * 2 + (c >> 5), rr = r & 15, cc = c & 31, ob = rr * 64 + cc * 2; return st * 1024 + (ob ^ (((ob >> 9) & 1) << 5)); }
__host__ __device__ __forceinline__ void stage_rc(int b, int& R, int& C) { const int st = b / 1024, sb = b % 1024, swz = sb ^ (((sb >> 9) & 1) << 5); R = (st >> 1) * 16 + swz / 64; C = (st & 1) * 32 + (swz % 64) / 2; }
__host__ __device__ __forceinline__ int perm32(int rho) { const int n = rho >> 4, i = rho & 15; return 8 * (i >> 2) + 4 * n + (i & 3); }

struct Unit { int pm, pn, e, lt; };
struct Gemm { const bf16_t* A; const bf16_t* Bt; int M, N, K; };

struct StaticOrder {
    int nM, nN, nwg, G, c;
    __host__ __device__ void init(int M, int N, int G_, int c_) { nM = M / BM; nN = N / BM; nwg = nM * nN; G = G_; c = c_; }
    __host__ __device__ bool next(int i, Unit& u) const {
        const long L = (long)i * G + c; if (L >= nwg) return false;
        int wgid = (int)L; { const int q = nwg / NXCD, r = nwg % NXCD, xcd = wgid % NXCD, off = wgid / NXCD; wgid = (xcd < r ? xcd * (q + 1) : r * (q + 1) + (xcd - r) * q) + off; }
        const int nig = WGM * nN, gid = wgid / nig, fm = gid * WGM, gsz = (nM - fm) < WGM ? (nM - fm) : WGM;
        u.pm = fm + ((wgid % nig) % gsz); u.pn = (wgid % nig) / gsz; u.e = 0; u.lt = 0; return true;
    }
    __device__ __forceinline__ void a_ready(const Unit&) const {}
    __device__ __forceinline__ void done(const Unit&) const {}
};

__device__ __forceinline__ unsigned cvt_pk_bf16(float lo, float hi) { unsigned r; asm volatile("v_cvt_pk_bf16_f32 %0, %1, %2" : "=v"(r) : "v"(lo), "v"(hi)); return r; }
typedef float f32x2 __attribute__((ext_vector_type(2)));

struct EpiProj {
    static constexpr bool PERM = true, AFTER_DRAIN = false;
    bf16_t *Qd, *Kd, *Vd, *Qs, *Ks, *Vs; float c2;
    __device__ __forceinline__ void operator()(const f32x4 (&acc)[2][2][4][2], const Unit& u, int wr, int wc, int fr, int fq) const {
        const int sec = u.pn >> 1;
        const float sc = sec == 0 ? c2 : (sec == 3 ? 0.125f : 1.f);
        const int row0 = u.pm * BM + wr * 64 + fr;
#pragma unroll
        for (int ai = 0; ai < 2; ++ai)
#pragma unroll
            for (int m = 0; m < 4; ++m) {
                const int row = row0 + ai * HALF + m * 16, b = row >> 13, fi = row & 8191, tile = fi >> 6, key = fi & 63;
#pragma unroll
                for (int bj = 0; bj < 2; ++bj) {
                    const int cc = (u.pn & 1) * 256 + bj * HALF + wc * 32 + 8 * fq;
                    const f32x4 v0 = acc[ai][bj][m][0] * sc, v1 = acc[ai][bj][m][1] * sc;
                    u32x4 w; w.x = cvt_pk_bf16(v0[0], v0[1]); w.y = cvt_pk_bf16(v0[2], v0[3]); w.z = cvt_pk_bf16(v1[0], v1[1]); w.w = cvt_pk_bf16(v1[2], v1[3]);
                    bf16_t* p;
                    if (sec == 0) p = Qd + (size_t)row * 512 + cc;
                    else if (sec == 3) p = Qs + (size_t)row * 512 + cc;
                    else if (sec == 1) { const int h = cc >> 7, s = (cc >> 6) & 1, ch = (cc & 63) >> 3; p = Kd + (size_t)(((b * 4 + h) * 2 + s) * 128 + tile) * 4096 + ch * 512 + key * 8; }
                    else if (sec == 2) { const int h = cc >> 7, d = cc & 127; p = Vd + (size_t)((b * 4 + h) * 128 + tile) * 8192 + (d >> 5) * 2048 + key * 32 + (d & 31); }
                    else if (sec == 4) { const int h = cc >> 6, ch = (cc & 63) >> 3; p = Ks + (size_t)((b * 8 + h) * 128 + tile) * 4096 + ch * 512 + key * 8; }
                    else { const int h = cc >> 6, d = cc & 63; p = Vs + (size_t)((b * 8 + h) * 128 + tile) * 4096 + (d >> 5) * 2048 + key * 32 + (d & 31); }
                    *(u32x4*)p = w;
                }
            }
    }
};
struct EpiRes {
    static constexpr bool PERM = false, AFTER_DRAIN = false;
    const float* base; float* out; int ldc;
    __device__ __forceinline__ void operator()(const f32x4 (&acc)[2][2][4][2], const Unit& u, int wr, int wc, int fr, int fq) const {
        const int row0 = u.pm * BM + wr * 64 + fr, col0 = u.pn * BM + wc * 32 + 4 * fq;
#pragma unroll
        for (int ai = 0; ai < 2; ++ai)
#pragma unroll
            for (int m = 0; m < 4; ++m) { const size_t off = (size_t)(row0 + ai * HALF + m * 16) * ldc + col0;
#pragma unroll
                for (int bj = 0; bj < 2; ++bj)
#pragma unroll
                    for (int n = 0; n < 2; ++n) { const f32x4 bs = *(const f32x4*)(base + off + bj * HALF + n * 16); *(f32x4*)(out + off + bj * HALF + n * 16) = bs + acc[ai][bj][m][n]; } }
    }
};
__device__ __forceinline__ float silu_mul(float g, float u) { return g * __builtin_amdgcn_rcpf(1.0f + __builtin_amdgcn_exp2f(-1.4426950408889634f * g)) * u; }
struct EpiSwiGLU {
    static constexpr bool PERM = true, AFTER_DRAIN = false;
    bf16_t* H;
    __device__ __forceinline__ void operator()(const f32x4 (&acc)[2][2][4][2], const Unit& u, int wr, int wc, int fr, int fq) const {
        const int row0 = u.pm * BM + wr * 64 + fr, col0 = (u.pn & 3) * 128 + wc * 32 + 8 * fq;
#pragma unroll
        for (int ai = 0; ai < 2; ++ai)
#pragma unroll
            for (int m = 0; m < 4; ++m) {
                const f32x4 g0 = acc[ai][0][m][0], g1 = acc[ai][0][m][1], u0 = acc[ai][1][m][0], u1 = acc[ai][1][m][1];
                u32x4 w; w.x = cvt_pk_bf16(silu_mul(g0[0], u0[0]), silu_mul(g0[1], u0[1])); w.y = cvt_pk_bf16(silu_mul(g0[2], u0[2]), silu_mul(g0[3], u0[3]));
                w.z = cvt_pk_bf16(silu_mul(g1[0], u1[0]), silu_mul(g1[1], u1[1])); w.w = cvt_pk_bf16(silu_mul(g1[2], u1[2]), silu_mul(g1[3], u1[3]));
                *(u32x4*)(H + (size_t)(row0 + ai * HALF + m * 16) * 512 + col0) = w;
            }
    }
};
struct EpiY {
    static constexpr bool PERM = true, AFTER_DRAIN = false;
    bf16_t* Y;
    __device__ __forceinline__ void operator()(const f32x4 (&acc)[2][2][4][2], const Unit& u, int wr, int wc, int fr, int fq) const {
        const int row0 = u.pm * BM + wr * 64 + fr, col0 = (u.pn & 3) * BM + wc * 32 + 8 * fq;
#pragma unroll
        for (int ai = 0; ai < 2; ++ai)
#pragma unroll
            for (int m = 0; m < 4; ++m) { bf16_t* rowp = Y + (size_t)(row0 + ai * HALF + m * 16) * 1024 + col0;
#pragma unroll
                for (int bj = 0; bj < 2; ++bj) { const f32x4 v0 = acc[ai][bj][m][0], v1 = acc[ai][bj][m][1];
                    u32x4 w; w.x = cvt_pk_bf16(v0[0], v0[1]); w.y = cvt_pk_bf16(v0[2], v0[3]); w.z = cvt_pk_bf16(v1[0], v1[1]); w.w = cvt_pk_bf16(v1[2], v1[3]);
                    *(u32x4*)(rowp + bj * HALF) = w; } }
    }
};
struct GroupedOrder {
    int pre[17], cnt[16]; const int* list; int G, c;
    __device__ __forceinline__ void init(const unsigned* gcnt, const int* list_, int G_, int c_) {
        list = list_; G = G_; c = c_; int a = 0;
#pragma unroll
        for (int e = 0; e < 16; ++e) { cnt[e] = __builtin_amdgcn_readfirstlane((int)__hip_atomic_load(gcnt + 64 * e, __ATOMIC_RELAXED, __HIP_MEMORY_SCOPE_AGENT)); pre[e] = a; a += (cnt[e] + 255) >> 8; }
        pre[16] = a;
    }
    __device__ __forceinline__ bool next(int i, Unit& u) const {
        const int L = i * G + c, rt = L >> 2; if (rt >= pre[16]) return false;
        int e = 0, pe = 0;
#pragma unroll
        for (int k = 1; k < 16; ++k) if (rt >= pre[k]) { e = k; pe = pre[k]; }
        u.pm = rt; u.pn = e * 4 + (L & 3); u.e = e; u.lt = rt - pe; return true;
    }
    __device__ __forceinline__ void a_ready(const Unit&) const {}
    __device__ __forceinline__ void done(const Unit&) const {}
    __device__ __forceinline__ void gather(const Unit& u, const int (&RA)[2], const int (&CA)[2], int K, unsigned (&v)[2][2]) const {
        int ce = 1;
#pragma unroll
        for (int k = 0; k < 16; ++k) if (u.e == k) ce = cnt[k];
        const int* lp = list + u.e * 16384;
#pragma unroll
        for (int h = 0; h < 2; ++h)
#pragma unroll
            for (int i = 0; i < 2; ++i) { int pos = u.lt * 256 + h * HALF + RA[i]; pos = pos < ce ? pos : ce - 1; const int tok = lp[pos]; v[h][i] = (unsigned)(tok * K + CA[i]) * 2u; }
#pragma unroll
        for (int h = 0; h < 2; ++h)
#pragma unroll
            for (int i = 0; i < 2; ++i) asm volatile("" : "+v"(v[h][i]) :: "memory");
    }
};
template <class Epi, class Sched, bool ALIGN_EPI = false, bool SP2 = false, bool GATHER = false>
__device__ __forceinline__ void gemm_phase(PG8_LAS unsigned char* lds, const Gemm g, const Sched& S, const Epi& E) {
    const int tid = threadIdx.x, wid = __builtin_amdgcn_readfirstlane(tid >> 6), lane = tid & 63, wr = wid >> 2, wc = wid & 3, fr = lane & 15, fq = lane >> 4;
    const int K = g.K, nt = K / BK;
    unsigned vc[2][2], vn[2][2], voffB[2]; int RA[2], CA[2];
#pragma unroll
    for (int i = 0; i < 2; ++i) { int R, C; stage_rc(tid * 16 + i * 8192, R, C); const int Rb = Epi::PERM ? ((R & ~31) + perm32(R & 31)) : R; RA[i] = R; CA[i] = C;
        vc[0][i] = (unsigned)(R * K + C) * 2u; vc[1][i] = (unsigned)((R + HALF) * K + C) * 2u; vn[0][i] = vc[0][i]; vn[1][i] = vc[1][i]; voffB[i] = (unsigned)(Rb * K + C) * 2u; }
    const size_t kstep = (size_t)(BK * 2);
    const size_t hstep = (size_t)HALF * K * 2;
    const size_t tstep = 2 * hstep;
    const unsigned ldsw = (unsigned)wid * 1024u;
    const int aoff = lds_byte(wr * 64 + fr, fq * 8), boff = lds_byte(wc * 32 + fr, fq * 8);
#define PG8_SA(b, h) (((b) * 2 + (h)) * HTB)
#define PG8_AP(p, h) ((p) + (GATHER ? (size_t)0 : (size_t)(h) * hstep))
#define PG8_AV(X, h) (GATHER ? X[h] : vc[0])
#define PG8_SB(b, h) ((4 + (b) * 2 + (h)) * HTB)
#define PG8_STAGE(bufoff, gbase, voff) do { _Pragma("unroll") for (int _i = 0; _i < 2; ++_i) \
        __builtin_amdgcn_global_load_lds((const unsigned*)((const char*)(gbase) + (voff)[_i]), (PG8_LAS unsigned*)(lds + (bufoff) + ldsw + _i * 8192), 16, 0, 0); } while (0)
#define PG8_LDA(dst, b, h) do { _Pragma("unroll") for (int m = 0; m < 4; ++m) _Pragma("unroll") for (int k = 0; k < 2; ++k) dst[m][k] = *(const PG8_LAS bf16x8*)(lds + PG8_SA(b, h) + aoff + m * 2048 + k * 1024); } while (0)
#define PG8_LDB(dst, b, h) do { _Pragma("unroll") for (int n = 0; n < 2; ++n) _Pragma("unroll") for (int k = 0; k < 2; ++k) dst[n][k] = *(const PG8_LAS bf16x8*)(lds + PG8_SB(b, h) + boff + n * 2048 + k * 1024); } while (0)
#define PG8_MMA(ai, bj, At, Bt) do { __builtin_amdgcn_s_setprio(1); _Pragma("unroll") for (int m = 0; m < 4; ++m) _Pragma("unroll") for (int n = 0; n < 2; ++n) _Pragma("unroll") for (int k = 0; k < 2; ++k) \
        acc[ai][bj][m][n] = __builtin_amdgcn_mfma_f32_16x16x32_bf16(Bt[n][k], At[m][k], acc[ai][bj][m][n], 0, 0, 0); __builtin_amdgcn_s_setprio(0); } while (0)
#define PG8_WAIT_V(n) asm volatile("s_waitcnt vmcnt(" #n ")" ::: "memory")
#define PG8_WAIT_L(n) asm volatile("s_waitcnt lgkmcnt(" #n ")" ::: "memory")
#define PG8_BAR __builtin_amdgcn_s_barrier()
#define PG8_SCHED __builtin_amdgcn_sched_barrier(0)
    Unit cur, nxt; int ui = 0;
    if (!S.next(0, cur)) return;
    f32x4 acc[2][2][4][2];
#pragma unroll
    for (int a = 0; a < 2; ++a)
#pragma unroll
        for (int b = 0; b < 2; ++b)
#pragma unroll
            for (int m = 0; m < 4; ++m)
#pragma unroll
                for (int n = 0; n < 2; ++n) acc[a][b][m][n] = (f32x4){0.f, 0.f, 0.f, 0.f};
    bf16x8 At[4][2], B0[2][2], B1[2][2];
    const char* cA = (const char*)g.A + (GATHER ? (size_t)0 : (size_t)cur.pm * tstep); const char* cB = (const char*)g.Bt + (size_t)cur.pn * tstep;
    if constexpr (GATHER) S.gather(cur, RA, CA, K, vc);
    S.a_ready(cur);
    if constexpr (SP2) {
        PG8_STAGE(PG8_SB(0, 0), cB, voffB); PG8_STAGE(PG8_SB(0, 1), cB + hstep, voffB); PG8_STAGE(PG8_SA(0, 0), PG8_AP(cA, 0), PG8_AV(vc, 0)); PG8_STAGE(PG8_SA(0, 1), PG8_AP(cA, 1), PG8_AV(vc, 1));
        if (wr == 1) PG8_BAR;
        PG8_WAIT_V(2); PG8_BAR;
        PG8_STAGE(PG8_SB(1, 0), cB + kstep, voffB); PG8_STAGE(PG8_SA(1, 0), PG8_AP(cA + kstep, 0), PG8_AV(vc, 0)); PG8_STAGE(PG8_SB(1, 1), cB + hstep + kstep, voffB);
        PG8_WAIT_V(6); PG8_BAR;
    } else {
        PG8_STAGE(PG8_SB(0, 0), cB, voffB); PG8_STAGE(PG8_SA(0, 0), PG8_AP(cA, 0), PG8_AV(vc, 0)); PG8_STAGE(PG8_SB(0, 1), cB + hstep, voffB); PG8_STAGE(PG8_SA(0, 1), PG8_AP(cA, 1), PG8_AV(vc, 1));
        if (wr == 1) PG8_BAR;
        PG8_WAIT_V(4); PG8_BAR;
        PG8_STAGE(PG8_SB(1, 0), cB + kstep, voffB); PG8_STAGE(PG8_SA(1, 0), PG8_AP(cA + kstep, 0), PG8_AV(vc, 0)); PG8_STAGE(PG8_SB(1, 1), cB + hstep + kstep, voffB);
        PG8_WAIT_V(6); PG8_BAR;
    }
    for (;;) {
        const bool has_next = S.next(ui + 1, nxt);
        const char* nA = (has_next && !GATHER) ? (const char*)g.A + (size_t)nxt.pm * tstep : cA; const char* nB = has_next ? (const char*)g.Bt + (size_t)nxt.pn * tstep : cB;
        if constexpr (GATHER) { if (has_next) S.gather(nxt, RA, CA, K, vn); else {
#pragma unroll
            for (int h_ = 0; h_ < 2; ++h_)
#pragma unroll
                for (int i_ = 0; i_ < 2; ++i_) vn[h_][i_] = vc[h_][i_]; } }
        for (int t = 0; t < nt; t += 2) {
            const bool last = (t == nt - 2);
            const char* a1 = cA + (size_t)(t + 1) * kstep;
            const char* a2 = last ? nA : cA + (size_t)(t + 2) * kstep; const char* b2 = last ? nB : cB + (size_t)(t + 2) * kstep;
            const char* a3 = a2 + kstep; const char* b3 = b2 + kstep;
            unsigned s2[2][2];
#pragma unroll
            for (int h_ = 0; h_ < 2; ++h_)
#pragma unroll
                for (int i_ = 0; i_ < 2; ++i_) s2[h_][i_] = (GATHER && last) ? vn[h_][i_] : vc[h_][i_];
            if (last && has_next) S.a_ready(nxt);
            if constexpr (SP2) {
            PG8_LDB(B0, 0, 0); PG8_LDB(B1, 0, 1); PG8_SCHED; PG8_LDA(At, 0, 0); PG8_STAGE(PG8_SA(1, 1), PG8_AP(a1, 1), PG8_AV(vc, 1));
            PG8_WAIT_V(8); PG8_WAIT_L(0); PG8_BAR; PG8_MMA(0, 0, At, B0); PG8_MMA(0, 1, At, B1); PG8_BAR; PG8_SCHED;
            PG8_LDA(At, 0, 1); PG8_STAGE(PG8_SB(0, 0), b2, voffB); PG8_STAGE(PG8_SB(0, 1), b2 + hstep, voffB); PG8_STAGE(PG8_SA(0, 0), PG8_AP(a2, 0), PG8_AV(s2, 0));
            PG8_WAIT_V(8); PG8_WAIT_L(0); PG8_BAR; PG8_MMA(1, 0, At, B0); PG8_MMA(1, 1, At, B1); PG8_BAR; PG8_SCHED;
            PG8_LDB(B0, 1, 0); PG8_LDB(B1, 1, 1); PG8_SCHED; PG8_LDA(At, 1, 0); PG8_STAGE(PG8_SA(0, 1), PG8_AP(a2, 1), PG8_AV(s2, 1));
            PG8_WAIT_V(8); PG8_WAIT_L(0); PG8_BAR; PG8_MMA(0, 0, At, B0); PG8_MMA(0, 1, At, B1); PG8_BAR; PG8_SCHED;
            PG8_LDA(At, 1, 1); PG8_STAGE(PG8_SB(1, 0), b3, voffB); PG8_STAGE(PG8_SB(1, 1), b3 + hstep, voffB); PG8_STAGE(PG8_SA(1, 0), PG8_AP(a3, 0), PG8_AV(s2, 0));
            PG8_WAIT_V(8); PG8_WAIT_L(0); PG8_BAR; PG8_MMA(1, 0, At, B0); PG8_MMA(1, 1, At, B1); PG8_BAR; PG8_SCHED;
            } else {
            PG8_LDB(B0, 0, 0); PG8_SCHED; PG8_LDA(At, 0, 0); PG8_STAGE(PG8_SA(1, 1), PG8_AP(a1, 1), PG8_AV(vc, 1));
            PG8_WAIT_L(8); PG8_BAR; PG8_WAIT_L(0); PG8_MMA(0, 0, At, B0); PG8_BAR; PG8_SCHED;
            PG8_LDB(B1, 0, 1); PG8_STAGE(PG8_SB(0, 0), b2, voffB);
            PG8_BAR; PG8_WAIT_L(0); PG8_MMA(0, 1, At, B1); PG8_BAR;
            PG8_LDA(At, 0, 1); PG8_STAGE(PG8_SA(0, 0), PG8_AP(a2, 0), PG8_AV(s2, 0));
            PG8_BAR; PG8_WAIT_L(0); PG8_MMA(1, 0, At, B0); PG8_BAR; PG8_SCHED;
            PG8_STAGE(PG8_SB(0, 1), b2 + hstep, voffB);
            PG8_WAIT_V(6); PG8_BAR; PG8_MMA(1, 1, At, B1); PG8_BAR;
            PG8_LDB(B0, 1, 0); PG8_SCHED; PG8_LDA(At, 1, 0); PG8_STAGE(PG8_SA(0, 1), PG8_AP(a2, 1), PG8_AV(s2, 1));
            PG8_WAIT_L(8); PG8_BAR; PG8_WAIT_L(0); PG8_MMA(0, 0, At, B0); PG8_BAR; PG8_SCHED;
            PG8_LDB(B1, 1, 1); PG8_STAGE(PG8_SB(1, 0), b3, voffB);
            PG8_BAR; PG8_WAIT_L(0); PG8_MMA(0, 1, At, B1); PG8_BAR;
            PG8_LDA(At, 1, 1); PG8_STAGE(PG8_SA(1, 0), PG8_AP(a3, 0), PG8_AV(s2, 0));
            PG8_BAR; PG8_WAIT_L(0); PG8_MMA(1, 0, At, B0); PG8_BAR; PG8_SCHED;
            PG8_STAGE(PG8_SB(1, 1), b3 + hstep, voffB);
            PG8_WAIT_V(6); PG8_BAR; PG8_MMA(1, 1, At, B1); PG8_BAR;
            }
        }
        if constexpr (ALIGN_EPI) { if (wr == 0) PG8_BAR; }
        if constexpr (!Epi::AFTER_DRAIN) { E(acc, cur, wr, wc, fr, fq); S.done(cur); }
        if (!has_next) break;
#pragma unroll
        for (int a = 0; a < 2; ++a)
#pragma unroll
            for (int b = 0; b < 2; ++b)
#pragma unroll
                for (int m = 0; m < 4; ++m)
#pragma unroll
                    for (int n = 0; n < 2; ++n) acc[a][b][m][n] = (f32x4){0.f, 0.f, 0.f, 0.f};
        cur = nxt; cA = nA; cB = nB; ++ui;
        if constexpr (GATHER) {
#pragma unroll
            for (int h_ = 0; h_ < 2; ++h_)
#pragma unroll
                for (int i_ = 0; i_ < 2; ++i_) vc[h_][i_] = vn[h_][i_]; }
        if constexpr (ALIGN_EPI) { if (wr == 1) PG8_BAR; }
    }
    PG8_WAIT_V(0);
    if constexpr (!ALIGN_EPI) { if (wr == 0) PG8_BAR; }
    PG8_BAR;
    if constexpr (Epi::AFTER_DRAIN) { E.fused(acc, cur, wr, wc, fr, fq, lds, wid, lane); S.done(cur); }
#undef PG8_SA
#undef PG8_AP
#undef PG8_AV
#undef PG8_SB
#undef PG8_STAGE
#undef PG8_LDA
#undef PG8_LDB
#undef PG8_MMA
#undef PG8_WAIT_V
#undef PG8_WAIT_L
#undef PG8_BAR
#undef PG8_SCHED
}
}

constexpr int NB = 2, T = 8192, D = 1024, M = NB * T;
constexpr int NPROJ = 3072, NEXP = 16, DEXP = 512, NMETA = 16;
constexpr float EPS = 1e-6f, LOG2E = 1.4426950408889634f;
constexpr float C2 = 0.125f * LOG2E;
constexpr float LAMBDA_INIT = 0.2f;
constexpr int SLOT_ROWS = 36864;

constexpr size_t MiB = 1u << 20;
constexpr size_t WS_CTL = 0, CTL_ZERO_BYTES = 1 * MiB;
constexpr size_t WS_WIN = 2 * MiB, WS_WOUT = 8 * MiB, WS_WGU = 10 * MiB, WS_WD = 42 * MiB;
constexpr size_t WS_HN = 58 * MiB;
constexpr size_t WS_QD = 90 * MiB, WS_KD = 106 * MiB, WS_VD = 122 * MiB, WS_QS = 138 * MiB, WS_KS = 154 * MiB, WS_VS = 170 * MiB;
constexpr size_t WS_HN2 = 90 * MiB;
constexpr size_t WS_HID = 122 * MiB;
constexpr size_t WS_Y = 158 * MiB;
constexpr size_t WS_META = 232 * MiB;
constexpr size_t WS_LIST = 233 * MiB;
constexpr size_t WS_TOKE = 234 * MiB;
constexpr size_t WS_TOKW = 235 * MiB;
constexpr size_t WS_END = 256 * MiB;
static_assert(WS_HID + (size_t)SLOT_ROWS * 512 * 2 <= WS_Y && WS_Y + (size_t)SLOT_ROWS * 1024 * 2 <= WS_META, "d_ws map");
constexpr int CW_TMO = 0, CW_CNT = 1024  , CW_BAR = 4096;

constexpr int RING_OFF = 0, RING_BYTES = 131072;
constexpr int LDSCTL_OFF = RING_BYTES, MISC_OFF = LDSCTL_OFF + 320;
constexpr int LDS_BYTES = 147456;
constexpr int NWAVES = 8;

#define GAS __attribute__((address_space(1)))
#define LAS __attribute__((address_space(3)))
typedef unsigned short bf16;
typedef unsigned v4u __attribute__((ext_vector_type(4)));
typedef unsigned v2u __attribute__((ext_vector_type(2)));
typedef float f32x4 __attribute__((ext_vector_type(4)));
typedef short bf16x8 __attribute__((ext_vector_type(8)));
typedef GAS unsigned gu32;
typedef GAS unsigned long long gu64;
#define RLX_AGENT __ATOMIC_RELAXED, __HIP_MEMORY_SCOPE_AGENT
#define LDS_WAIT() asm volatile("s_waitcnt lgkmcnt(0)" ::: "memory")
#define VM_WAIT() asm volatile("s_waitcnt vmcnt(0)" ::: "memory")
__device__ __forceinline__ unsigned f2bf(float f) { unsigned u = __builtin_bit_cast(unsigned, f); return (u + 0x7fffu + ((u >> 16) & 1u)) >> 16; }
__device__ __forceinline__ unsigned pk2(float lo, float hi) { return f2bf(lo) | (f2bf(hi) << 16); }
__device__ __forceinline__ float bf2f(unsigned short h) { return __builtin_bit_cast(float, (unsigned)h << 16); }
#define XB_TMO      128
#define XB_XCNT(j)  (256  + 64 * (j))
#define XB_XSUB(j)  (1280 + 64 * (j))
#define XB_XGEN(j)  (2304 + 64 * (j))
#define XB_TOP      3328
#define XB_TOPGEN   3392
#define XCD_BAR_WORDS 3456
#define XB_SPIN_CAP (1u << 18)

__device__ __forceinline__ unsigned xb_ld(unsigned* p)              { return __hip_atomic_load(p, __ATOMIC_RELAXED, __HIP_MEMORY_SCOPE_AGENT); }
__device__ __forceinline__ unsigned xb_add(unsigned* p, unsigned v) { return __hip_atomic_fetch_add(p, v, __ATOMIC_RELAXED, __HIP_MEMORY_SCOPE_AGENT); }
__device__ __forceinline__ unsigned xb_xcc_id() { return (unsigned)__builtin_amdgcn_s_getreg((3 << 11) | 20) & 0xFu; }
#define XB_SPIN(cond, bar) do { unsigned _sp = 0; while (cond) { __builtin_amdgcn_s_sleep(1); \
    if ((++_sp & 255u) == 0u) { if (xb_ld(&(bar)[XB_TMO])) break; if (_sp > XB_SPIN_CAP) { atomicAdd(&(bar)[XB_TMO], 1u); break; } } } } while (0)

struct XcdBarrier {
    unsigned* bar; unsigned x;
    volatile LAS unsigned* st;
};

__device__ __forceinline__ XcdBarrier xcd_barrier_post(unsigned* bar, volatile LAS unsigned* st) {
    XcdBarrier b; b.bar = bar; b.x = xb_xcc_id(); b.st = st;
    if (threadIdx.x == 0) (void)xb_add(&bar[XB_XCNT(b.x)], 1u);
    return b;
}
__device__ __forceinline__ void xcd_barrier_complete(unsigned* bar, unsigned x, unsigned& nloc, unsigned& nx) {
    const unsigned G = gridDim.x * gridDim.y * gridDim.z;
    unsigned sum, cnt, mine, sp = 0u;
    for (;;) {
        sum = 0u; cnt = 0u; mine = 0u;
#pragma unroll
        for (unsigned j = 0; j < 16; ++j) { const unsigned c = xb_ld(&bar[XB_XCNT(j)]); sum += c; cnt += (c > 0u) ? 1u : 0u; mine = (j == x) ? c : mine; }
        if (sum == G) break;
        __builtin_amdgcn_s_sleep(1);
        if ((++sp & 255u) == 0u) { if (xb_ld(&bar[XB_TMO])) break; if (sp > XB_SPIN_CAP) { atomicAdd(&bar[XB_TMO], 1u); break; } }
    }
    nloc = mine > 0u ? mine : 1u; nx = cnt > 0u ? cnt : 1u;
}

__device__ __forceinline__ void xcd_barrier(const XcdBarrier& b) {
    asm volatile("s_waitcnt vmcnt(0)" ::: "memory");
    __syncthreads();
    if (threadIdx.x == 0) {
        unsigned* bar = b.bar;
        __builtin_amdgcn_s_waitcnt(0);
        unsigned nloc = b.st[0], nx = b.st[1];
        if (nloc == 0u) { xcd_barrier_complete(bar, b.x, nloc, nx); b.st[0] = nloc; b.st[1] = nx; }
        const unsigned old = xb_add(&bar[XB_XSUB(b.x)], 1u);
        const unsigned gen = old / nloc;
        if (old + 1u == (gen + 1u) * nloc) {
            __builtin_amdgcn_fence(__ATOMIC_RELEASE, "agent");
            asm volatile("s_waitcnt vmcnt(0)" ::: "memory");
            const unsigned og = xb_add(&bar[XB_TOP], 1u);
            const unsigned tg = og / nx;
            if (og + 1u == (tg + 1u) * nx) xb_add(&bar[XB_TOPGEN], 1u);
            else XB_SPIN(xb_ld(&bar[XB_TOPGEN]) == tg, bar);
            __builtin_amdgcn_fence(__ATOMIC_ACQUIRE, "agent");
            xb_add(&bar[XB_XGEN(b.x)], 1u);
            asm volatile("s_waitcnt vmcnt(0)" ::: "memory");
        } else {
            XB_SPIN(xb_ld(&bar[XB_XGEN(b.x)]) == gen, bar);
            __builtin_amdgcn_fence(__ATOMIC_ACQUIRE, "agent");
            asm volatile("s_waitcnt vmcnt(0)" ::: "memory");
        }
    }
    __syncthreads();
}

struct Frame {
    LAS unsigned char* lds;
    volatile LAS unsigned* MISC;
    gu32* ctl;
    int tid, lane, wave, vcu, G;
    const float *x, *meta, *rel_table, *attn_norm, *w_in, *lq1, *lk1, *lq2, *lk2, *diff_norm, *sb_norm, *w_out, *ffn_norm, *w_group, *w_router, *w_gate, *w_up, *w_down, *final_norm;
    float* out;
    bf16 *Win_t, *Wout_t, *Wgu_t, *Wd_t;
    bf16 *HN, *MIX, *QD, *KD, *VD, *QS, *KS, *VS, *HN2, *HID, *Y, *KDM, *VDM, *KSM, *VSM;
    int* list; int* toke; float* tokw;
};

__device__ __forceinline__ float wave_sum(float v) {
#pragma unroll
    for (int o = 1; o < 64; o <<= 1) v += __shfl_xor(v, o);
    return v;
}
__device__ __forceinline__ void p0_transpose_item(const float* W, int K, int N, bf16* WT, int drow0, LAS float* scr, int k0, int n0, int lane) {
#pragma unroll 8
    for (int i = 0; i < 32; ++i) { const int kk = 2 * i + (lane >> 5); scr[kk * 33 + (lane & 31)] = W[(size_t)(k0 + kk) * N + n0 + (lane & 31)]; }
    LDS_WAIT(); asm volatile("" ::: "memory");
    const int c = lane & 7;
#pragma unroll
    for (int j = 0; j < 4; ++j) { const int n = (lane >> 3) + 8 * j; const LAS float* s = scr + (8 * c) * 33 + n;
        v4u o; o.x = pk2(s[0 * 33], s[1 * 33]); o.y = pk2(s[2 * 33], s[3 * 33]); o.z = pk2(s[4 * 33], s[5 * 33]); o.w = pk2(s[6 * 33], s[7 * 33]);
        *(GAS v4u*)(WT + (size_t)(drow0 + n) * K + k0 + 8 * c) = o; }
    LDS_WAIT(); asm volatile("" ::: "memory");
}
__device__ __forceinline__ void rms_row_to_bf16(int lane, const float* xrow, const float* gain, bf16* orow) {
    const GAS f32x4* xr = (const GAS f32x4*)xrow + lane; const GAS f32x4* gr = (const GAS f32x4*)gain + lane;
    f32x4 v[4]; float s = 0.f;
#pragma unroll
    for (int j = 0; j < 4; ++j) { v[j] = xr[64 * j]; s += (v[j].x * v[j].x + v[j].y * v[j].y) + (v[j].z * v[j].z + v[j].w * v[j].w); }
    const float rstd = 1.f / sqrtf(wave_sum(s) * (1.f / D) + EPS);
    GAS unsigned long long* o8 = (GAS unsigned long long*)orow + lane;
#pragma unroll
    for (int j = 0; j < 4; ++j) { const f32x4 g = gr[64 * j]; o8[64 * j] = (unsigned long long)pk2(v[j].x * rstd * g.x, v[j].y * rstd * g.y) | ((unsigned long long)pk2(v[j].z * rstd * g.z, v[j].w * rstd * g.w) << 32); }
}
__device__ __forceinline__ bf16* meta_addr(Frame& F, int col, int key) {
    const int sec = col >> 9, cc = col & 511;
    if (sec == 1) { const int h = cc >> 7, s = (cc >> 6) & 1, ch = (cc & 63) >> 3; return F.KDM + (h * 2 + s) * 4096 + ch * 512 + key * 8 + (cc & 7); }
    if (sec == 2) { const int h = cc >> 7, d = cc & 127; return F.VDM + h * 8192 + (d >> 5) * 2048 + key * 32 + (d & 31); }
    if (sec == 4) { const int h = cc >> 6, ch = (cc & 63) >> 3; return F.KSM + h * 4096 + ch * 512 + key * 8 + (cc & 7); }
    if (sec == 5) { const int h = cc >> 6, d = cc & 63; return F.VSM + h * 4096 + (d >> 5) * 2048 + key * 32 + (d & 31); }
    return nullptr;
}
__device__ __forceinline__ void p0_prologue(Frame& F) {
    const int gw = F.vcu * NWAVES + F.wave, NGW = F.G * NWAVES;
    for (int it = blockIdx.x; it < 32; it += F.G) {
        const int sec = it >> 3, sub = it & 7;
        const int colbase = (sec == 0 ? 512 : sec == 1 ? 1024 : sec == 2 ? 2048 : 2560) + sub * 64;
        LAS float* hnm = (LAS float*)(F.lds + RING_OFF);
        LAS float* red = (LAS float*)(F.lds + RING_OFF + 65536);
        for (int r = F.wave * 2; r < F.wave * 2 + 2; ++r) {
            const GAS f32x4* xr = (const GAS f32x4*)(F.meta + (size_t)r * D) + F.lane; const GAS f32x4* gr = (const GAS f32x4*)F.attn_norm + F.lane;
            f32x4 v[4]; float s = 0.f;
#pragma unroll
            for (int j = 0; j < 4; ++j) { v[j] = xr[64 * j]; s += (v[j].x * v[j].x + v[j].y * v[j].y) + (v[j].z * v[j].z + v[j].w * v[j].w); }
            const float rstd = 1.f / sqrtf(wave_sum(s) * (1.f / D) + EPS);
#pragma unroll
            for (int j = 0; j < 4; ++j) { const f32x4 g = gr[64 * j]; *(LAS f32x4*)(hnm + r * D + 256 * j + 4 * F.lane) = v[j] * rstd * g; }
        }
        __syncthreads();
        float acc[16];
#pragma unroll
        for (int m = 0; m < 16; ++m) acc[m] = 0.f;
        const float* wp = F.w_in + (size_t)(F.wave * 128) * NPROJ + colbase + F.lane;
        for (int k = 0; k < 128; k += 4) {
            const float w0 = wp[(size_t)(k + 0) * NPROJ], w1 = wp[(size_t)(k + 1) * NPROJ], w2 = wp[(size_t)(k + 2) * NPROJ], w3 = wp[(size_t)(k + 3) * NPROJ];
#pragma unroll
            for (int m = 0; m < 16; ++m) { const f32x4 h4 = *(const LAS f32x4*)(hnm + m * D + F.wave * 128 + k); acc[m] += (h4.x * w0 + h4.y * w1) + (h4.z * w2 + h4.w * w3); }
        }
#pragma unroll
        for (int m = 0; m < 16; ++m) red[(F.wave * 16 + m) * 64 + F.lane] = acc[m];
        __syncthreads();
        for (int idx = F.tid; idx < 1024; idx += NWAVES * 64) { const int m = idx >> 6, c = idx & 63; float s = 0.f;
#pragma unroll
            for (int w = 0; w < 8; ++w) s += red[(w * 16 + m) * 64 + c];
            *meta_addr(F, colbase + c, m) = (bf16)f2bf(s); }
        for (int idx = F.tid; idx < 48 * 64; idx += NWAVES * 64) { const int key = 16 + (idx >> 6), c = idx & 63; *meta_addr(F, colbase + c, key) = (bf16)0; }
        __syncthreads();
    }
    LAS float* scr = (LAS float*)(F.lds + RING_OFF + F.wave * 16384);
    constexpr int I_IN = 16 * 96, I_OUT = 16 * 32, I_G = 16 * 256, I_D = 16 * 256, NITEMS = I_IN + I_OUT + 2 * I_G + I_D;
    for (int it = gw; it < NITEMS; it += NGW) {
        int r = it;
        if (r < I_IN) { p0_transpose_item(F.w_in, D, NPROJ, F.Win_t, 32 * (r % 96), scr, 64 * (r / 96), 32 * (r % 96), F.lane); continue; } r -= I_IN;
        if (r < I_OUT) { p0_transpose_item(F.w_out, D, D, F.Wout_t, 32 * (r % 32), scr, 64 * (r / 32), 32 * (r % 32), F.lane); continue; } r -= I_OUT;
        if (r < 2 * I_G) { const int up = r >= I_G; if (up) r -= I_G; const int e = r >> 8, q = r & 255, n0 = 32 * (q % 16), k0 = 64 * (q / 16);
            p0_transpose_item((up ? F.w_up : F.w_gate) + (size_t)e * D * DEXP, D, DEXP, F.Wgu_t + (size_t)e * 1024 * D, (n0 >> 7) * 256 + up * 128 + (n0 & 127), scr, k0, n0, F.lane); continue; } r -= 2 * I_G;
        { const int e = r >> 8, q = r & 255, n0 = 32 * (q % 32), k0 = 64 * (q / 32);
            p0_transpose_item(F.w_down + (size_t)e * DEXP * D, DEXP, D, F.Wd_t + (size_t)e * D * DEXP, n0, scr, k0, n0, F.lane); }
    }
    for (int m = gw; m < M; m += NGW) rms_row_to_bf16(F.lane, F.x + (size_t)m * D, F.attn_norm, F.HN + (size_t)m * D);
}

__device__ __forceinline__ void p4_route(Frame& F) {
    LAS float* wl = (LAS float*)(F.lds + RING_OFF);
    LAS int* lcnt = (LAS int*)(F.lds + RING_OFF + 81920);
    LAS int* lbase = lcnt + 16;
    LAS int* rinfo = lcnt + 64;
    LAS float* rw = (LAS float*)(rinfo + 256);
    for (int idx = F.tid; idx < 1024 * 20; idx += NWAVES * 64) { const int k = idx / 20, o = idx % 20; wl[idx] = o < 4 ? F.w_group[k * 4 + o] : F.w_router[k * 16 + (o - 4)]; }
    const GAS f32x4* gr = (const GAS f32x4*)F.ffn_norm + F.lane;
    f32x4 g[4];
#pragma unroll
    for (int j = 0; j < 4; ++j) g[j] = gr[64 * j];
    for (int blk = blockIdx.x; blk < M / 64; blk += F.G) {
        if (F.tid < 16) lcnt[F.tid] = 0;
        __syncthreads();
        for (int r = 0; r < 8; ++r) {
            const int lr = F.wave * 8 + r, m = blk * 64 + lr;
            const GAS f32x4* xr = (const GAS f32x4*)(F.out + (size_t)m * D) + F.lane;
            f32x4 v[4]; float s = 0.f;
#pragma unroll
            for (int j = 0; j < 4; ++j) { v[j] = xr[64 * j]; s += (v[j].x * v[j].x + v[j].y * v[j].y) + (v[j].z * v[j].z + v[j].w * v[j].w); }
            const float rstd = 1.f / sqrtf(wave_sum(s) * (1.f / D) + EPS);
            GAS unsigned long long* o8 = (GAS unsigned long long*)(F.HN2 + (size_t)m * D) + F.lane;
            float lg[20];
#pragma unroll
            for (int o = 0; o < 20; ++o) lg[o] = 0.f;
#pragma unroll
            for (int j = 0; j < 4; ++j) { v[j] = v[j] * rstd * g[j];
                o8[64 * j] = (unsigned long long)pk2(v[j].x, v[j].y) | ((unsigned long long)pk2(v[j].z, v[j].w) << 32);
#pragma unroll
                for (int e = 0; e < 4; ++e) { const LAS f32x4* wp = (const LAS f32x4*)(wl + (256 * j + 4 * F.lane + e) * 20); const float xv = v[j][e];
#pragma unroll
                    for (int q = 0; q < 5; ++q) { const f32x4 w4 = wp[q]; lg[4 * q + 0] += xv * w4.x; lg[4 * q + 1] += xv * w4.y; lg[4 * q + 2] += xv * w4.z; lg[4 * q + 3] += xv * w4.w; } } }
#pragma unroll
            for (int o = 0; o < 20; ++o) lg[o] = wave_sum(lg[o]);
            int gi = 0; float gm = lg[0];
#pragma unroll
            for (int o = 1; o < 4; ++o) if (lg[o] > gm) { gm = lg[o]; gi = o; }
            float gs = 0.f;
#pragma unroll
            for (int o = 0; o < 4; ++o) gs += __expf(lg[o] - gm);
            const float gw_ = 1.f / gs;
            float el[4];
#pragma unroll
            for (int o = 0; o < 4; ++o) el[o] = gi == 0 ? lg[4 + o] : gi == 1 ? lg[8 + o] : gi == 2 ? lg[12 + o] : lg[16 + o];
            int i1 = 0; float m1 = el[0];
#pragma unroll
            for (int o = 1; o < 4; ++o) if (el[o] > m1) { m1 = el[o]; i1 = o; }
            int i2 = -1; float m2 = -3.0e38f;
#pragma unroll
            for (int o = 0; o < 4; ++o) if (o != i1 && el[o] > m2) { m2 = el[o]; i2 = o; }
            const float w1 = 1.f / (1.f + __expf(m2 - m1)), w2 = 1.f - w1;
            if (F.lane == 0) { const int ea = gi * 4 + i1, eb = gi * 4 + i2;
                rinfo[lr * 4 + 0] = ea; rinfo[lr * 4 + 1] = eb; rinfo[lr * 4 + 2] = __hip_atomic_fetch_add(&lcnt[ea], 1, __ATOMIC_RELAXED, __HIP_MEMORY_SCOPE_WORKGROUP); rinfo[lr * 4 + 3] = __hip_atomic_fetch_add(&lcnt[eb], 1, __ATOMIC_RELAXED, __HIP_MEMORY_SCOPE_WORKGROUP);
                rw[lr * 2 + 0] = gw_ * w1; rw[lr * 2 + 1] = gw_ * w2; }
        }
        __syncthreads();
        if (F.tid < 16) lbase[F.tid] = (int)__hip_atomic_fetch_add((unsigned*)(F.ctl + CW_CNT + 64 * F.tid), (unsigned)lcnt[F.tid], RLX_AGENT);
        __syncthreads();
        if (F.tid < 64) { const int lr = F.tid, m = blk * 64 + lr; const int ea = rinfo[lr * 4 + 0], eb = rinfo[lr * 4 + 1];
            const int pa = lbase[ea] + rinfo[lr * 4 + 2], pb = lbase[eb] + rinfo[lr * 4 + 3];
            F.list[ea * 16384 + pa] = m; F.list[eb * 16384 + pb] = m;
            F.toke[m * 2 + 0] = ea * 16384 + pa; F.toke[m * 2 + 1] = eb * 16384 + pb; F.tokw[m * 2 + 0] = rw[lr * 2 + 0]; F.tokw[m * 2 + 1] = rw[lr * 2 + 1]; }
        __syncthreads();
    }
}
__device__ __forceinline__ void p7_final(Frame& F) {
    LAS int* pre = (LAS int*)(F.lds + RING_OFF);
    if (F.tid == 0) { int a = 0; for (int e = 0; e < 16; ++e) { pre[e] = a * 256; a += ((int)__hip_atomic_load(F.ctl + CW_CNT + 64 * e, RLX_AGENT) + 255) >> 8; } }
    __syncthreads();
    const int gw = F.vcu * NWAVES + F.wave, NGW = F.G * NWAVES;
    const GAS f32x4* gr = (const GAS f32x4*)F.final_norm + F.lane;
    f32x4 g[4];
#pragma unroll
    for (int j = 0; j < 4; ++j) g[j] = gr[64 * j];
    for (int m = gw; m < M; m += NGW) {
        const int ta = (int)__hip_atomic_load((GAS unsigned*)F.toke + m * 2 + 0, RLX_AGENT), tb = (int)__hip_atomic_load((GAS unsigned*)F.toke + m * 2 + 1, RLX_AGENT);
        const float wa = __uint_as_float(__hip_atomic_load((GAS unsigned*)F.tokw + m * 2 + 0, RLX_AGENT)), wb = __uint_as_float(__hip_atomic_load((GAS unsigned*)F.tokw + m * 2 + 1, RLX_AGENT));
        const int sa = pre[ta >> 14] + (ta & 16383), sb = pre[tb >> 14] + (tb & 16383);
        GAS f32x4* xr = (GAS f32x4*)(F.out + (size_t)m * D) + F.lane;
        const GAS v2u* ya = (const GAS v2u*)(F.Y + (size_t)sa * D) + F.lane; const GAS v2u* yb = (const GAS v2u*)(F.Y + (size_t)sb * D) + F.lane;
        f32x4 v[4]; float s = 0.f;
#pragma unroll
        for (int j = 0; j < 4; ++j) { const f32x4 h = xr[64 * j]; const v2u a = ya[64 * j], b = yb[64 * j];
            v[j].x = h.x + wa * bf2f((unsigned short)(a.x & 0xffff)) + wb * bf2f((unsigned short)(b.x & 0xffff));
            v[j].y = h.y + wa * bf2f((unsigned short)(a.x >> 16)) + wb * bf2f((unsigned short)(b.x >> 16));
            v[j].z = h.z + wa * bf2f((unsigned short)(a.y & 0xffff)) + wb * bf2f((unsigned short)(b.y & 0xffff));
            v[j].w = h.w + wa * bf2f((unsigned short)(a.y >> 16)) + wb * bf2f((unsigned short)(b.y >> 16));
            s += (v[j].x * v[j].x + v[j].y * v[j].y) + (v[j].z * v[j].z + v[j].w * v[j].w); }
        const float rstd = 1.f / sqrtf(wave_sum(s) * (1.f / D) + EPS);
#pragma unroll
        for (int j = 0; j < 4; ++j) xr[64 * j] = v[j] * rstd * g[j];
    }
}

__device__ __forceinline__ int t5_bucket(int rel) {
    const int n = rel < 0 ? -rel : rel; int b;
    if (n < 8) b = n; else if (n < 12) b = 8; else if (n < 16) b = 9; else if (n < 23) b = 10; else if (n < 32) b = 11; else if (n < 46) b = 12; else if (n < 64) b = 13; else if (n < 91) b = 14; else b = 15;
    return b + (rel > 0 ? 16 : 0);
}
namespace att {
typedef float f32x16 __attribute__((ext_vector_type(16)));
typedef short s16x4 __attribute__((ext_vector_type(4)));
typedef short v4i16_t __attribute__((ext_vector_type(4)));
typedef float f32x2_t __attribute__((ext_vector_type(2))); typedef __bf16 bf16x2_t __attribute__((ext_vector_type(2)));
__device__ __forceinline__ unsigned cvtpk(float lo, float hi) { f32x2_t v = {lo, hi}; bf16x2_t b = __builtin_convertvector(v, bf16x2_t); return __builtin_bit_cast(unsigned, b); }
__device__ __forceinline__ int crow(int r, int hi) { return (r & 3) + 8 * (r >> 2) + 4 * hi; }
__device__ __forceinline__ s16x4 vtr(const LAS unsigned char* p) { return __builtin_bit_cast(s16x4, __builtin_amdgcn_ds_read_tr16_b64_v4i16((LAS v4i16_t*)p)); }
__device__ __forceinline__ void glds16(const void* gsrc, LAS unsigned char* ldst) { __builtin_amdgcn_global_load_lds((const unsigned*)gsrc, (LAS unsigned*)ldst, 16, 0, 0); }
__device__ __forceinline__ bf16x8 pack8(const f32x16& p, int b) { v4u w; w.x = cvtpk(p[b], p[b + 1]); w.y = cvtpk(p[b + 2], p[b + 3]); w.z = cvtpk(p[b + 4], p[b + 5]); w.w = cvtpk(p[b + 6], p[b + 7]); return __builtin_bit_cast(bf16x8, w); }
constexpr int L_LUT = 65536, L_DN = 69632, L_SN = 70144;
constexpr float NEG = -1.0e30f;

__device__ __forceinline__ void p2_tables(Frame& F) {
    LAS float* lut = (LAS float*)(F.lds + RING_OFF + L_LUT);
    for (int idx = F.tid; idx < 1024; idx += NWAVES * 64) { const int h = idx >> 8, rel = (idx & 255) - 191; lut[idx] = F.rel_table[t5_bucket(rel) * 4 + h] * LOG2E; }
    if (F.tid < 128) ((LAS float*)(F.lds + RING_OFF + L_DN))[F.tid] = F.diff_norm[F.tid];
    if (F.tid < 64) ((LAS float*)(F.lds + RING_OFF + L_SN))[F.tid] = F.sb_norm[F.tid];
}

__device__ __forceinline__ void diff_unit(Frame& F, int b, int h, int qb, float lam) {
    const int lane = F.lane, r = lane & 31, hh = lane >> 5, w = F.wave, s = w >> 2, wq = w & 3;
    const int r0 = qb * 128 + wq * 32, cw = r0 >> 6, NT = 2 * qb + 2;
    LAS unsigned char* L = F.lds + RING_OFF;
    bf16x8 qr[4];
    { const bf16* qp = F.QD + (size_t)(b * T + r0 + r) * 512 + h * 128 + s * 64 + hh * 8;
#pragma unroll
      for (int d0 = 0; d0 < 4; ++d0) qr[d0] = *(const bf16x8*)(qp + 16 * d0); }
    const int pk = w < 4 ? (w & 1) * 4 : (w - 4) * 4, ks = (w >> 1) & 1;
#define DIFF_ISSUE(t, bufo) do { const bf16* src_; \
        if (w < 4) src_ = (t) < 0 ? F.KDM + (h * 2 + ks) * 4096 : F.KD + (size_t)(((b * 4 + h) * 2 + ks) * 128 + (t)) * 4096; \
        else       src_ = (t) < 0 ? F.VDM + h * 8192 : F.VD + (size_t)((b * 4 + h) * 128 + (t)) * 8192; \
        _Pragma("unroll") for (int i_ = 0; i_ < 4; ++i_) glds16(src_ + (pk + i_) * 512 + lane * 8, L + (bufo) + (4 * w + i_) * 1024); } while (0)
    f32x16 o[4];
#pragma unroll
    for (int d = 0; d < 4; ++d) o[d] = f32x16{};
    float mrun = NEG, lrun = 0.f;
    const LAS float* lutb = (const LAS float*)(L + L_LUT) + h * 256;
    const float cfar = lutb[0];
    const int vlane = ((lane >> 4) & 1) * 32 + (lane & 3) * 8 + (4 * hh + ((lane & 15) >> 2)) * 64;
    int bufo = 0;
    DIFF_ISSUE(-1, 0);
    for (int t = -1; t < NT; ++t) {
        asm volatile("s_waitcnt vmcnt(0)" ::: "memory");
        __syncthreads();
        if (t + 1 < NT) DIFF_ISSUE(t + 1, bufo ^ 32768);
        if (t <= cw) {
            const LAS unsigned char* Kb = L + bufo + s * 8192 + hh * 1024 + r * 16;
            const LAS unsigned char* Vb = L + bufo + 16384 + vlane;
            f32x16 p0, p1;
            const int krel0 = (t < 0 ? -16 : 64 * t) - (r0 + r);
            const int maxrel = (t < 0 ? -1 : 64 * t + 63) - r0;
            if (maxrel > -91) {
                const LAS float* lp = lutb + 191 + krel0 + 4 * hh;
#pragma unroll
                for (int g = 0; g < 16; ++g) { p0[g] = lp[(g & 3) + 8 * (g >> 2)]; p1[g] = lp[32 + (g & 3) + 8 * (g >> 2)]; }
            } else {
#pragma unroll
                for (int g = 0; g < 16; ++g) { p0[g] = cfar; p1[g] = cfar; }
            }
            if (t < 0) {
#pragma unroll
                for (int g = 0; g < 16; ++g) { if (g >= 8) p0[g] = NEG; p1[g] = NEG; }
            }
#pragma unroll
            for (int d0 = 0; d0 < 4; ++d0) {
                const bf16x8 a0 = *(const LAS bf16x8*)(Kb + d0 * 2048), a1 = *(const LAS bf16x8*)(Kb + d0 * 2048 + 512);
                p0 = __builtin_amdgcn_mfma_f32_32x32x16_bf16(a0, qr[d0], p0, 0, 0, 0);
                p1 = __builtin_amdgcn_mfma_f32_32x32x16_bf16(a1, qr[d0], p1, 0, 0, 0);
            }
            float rm = fmaxf(p0[0], p1[0]);
#pragma unroll
            for (int g = 1; g < 16; ++g) rm = fmaxf(rm, fmaxf(p0[g], p1[g]));
            rm = fmaxf(rm, __shfl_xor(rm, 32));
            const float mn = fmaxf(mrun, rm), al = __builtin_amdgcn_exp2f(mrun - mn); mrun = mn;
            float ls = 0.f;
#pragma unroll
            for (int g = 0; g < 16; ++g) { p0[g] = __builtin_amdgcn_exp2f(p0[g] - mn); p1[g] = __builtin_amdgcn_exp2f(p1[g] - mn); ls += p0[g] + p1[g]; }
            lrun = lrun * al + ls;
#pragma unroll
            for (int d = 0; d < 4; ++d) o[d] *= al;
            bf16x8 pa[4]; pa[0] = pack8(p0, 0); pa[1] = pack8(p0, 8); pa[2] = pack8(p1, 0); pa[3] = pack8(p1, 8);
#pragma unroll
            for (int d = 0; d < 4; ++d)
#pragma unroll
                for (int k = 0; k < 4; ++k) {
                    const s16x4 lo = vtr(Vb + d * 4096 + k * 1024), hi = vtr(Vb + d * 4096 + k * 1024 + 512);
                    const bf16x8 vf = (bf16x8){lo[0], lo[1], lo[2], lo[3], hi[0], hi[1], hi[2], hi[3]};
                    o[d] = __builtin_amdgcn_mfma_f32_32x32x16_bf16(vf, pa[k], o[d], 0, 0, 0);
                }
        }
        bufo ^= 32768;
    }
#undef DIFF_ISSUE
    const float inv = 1.f / (lrun + __shfl_xor(lrun, 32));
    LAS float* stg = (LAS float*)L;
    __syncthreads();
    if (s == 1) {
#pragma unroll
        for (int d = 0; d < 4; ++d)
#pragma unroll
            for (int g = 0; g < 16; ++g) stg[(d * 16 + g) * 256 + wq * 64 + lane] = o[d][g] * inv;
    }
    __syncthreads();
    if (s == 0) {
        float ss = 0.f;
#pragma unroll
        for (int d = 0; d < 4; ++d)
#pragma unroll
            for (int g = 0; g < 16; ++g) { const float v = o[d][g] * inv - lam * stg[(d * 16 + g) * 256 + wq * 64 + lane]; o[d][g] = v; ss += v * v; }
        ss += __shfl_xor(ss, 32);
        const float rn = (1.f - LAMBDA_INIT) / sqrtf(ss * (1.f / 128.f) + EPS);
        const LAS float* dn = (const LAS float*)(L + L_DN);
        bf16* op = F.MIX + (size_t)(b * T + r0 + r) * D + h * 128 + 4 * hh;
#pragma unroll
        for (int d = 0; d < 4; ++d)
#pragma unroll
            for (int g4 = 0; g4 < 4; ++g4) { const f32x4 gn = *(const LAS f32x4*)(dn + d * 32 + 8 * g4 + 4 * hh);
                v2u pk; pk.x = cvtpk(o[d][4 * g4] * rn * gn.x, o[d][4 * g4 + 1] * rn * gn.y); pk.y = cvtpk(o[d][4 * g4 + 2] * rn * gn.z, o[d][4 * g4 + 3] * rn * gn.w);
                *(v2u*)(op + d * 32 + 8 * g4) = pk; }
    }
    __syncthreads();
}

__device__ __forceinline__ void sb_scan_block(const f32x16& z, int kb, int t, int i, int hh, float& C, f32x16& a) {
    float x[16], lsv[16]; bool val[16];
#pragma unroll
    for (int g = 0; g < 16; ++g) {
        const int key = kb + crow(g, hh);
        val[g] = t < 0 ? key < 16 : (64 * t + key) < i;
        const float zz = z[g], e = __builtin_amdgcn_exp2f(-fabsf(zz) * LOG2E), lg = __builtin_amdgcn_logf(1.f + e) * 0.6931471805599453f;
        lsv[g] = fminf(zz, 0.f) - lg; x[g] = val[g] ? lsv[g] - zz : 0.f;
    }
    float sg[4], sp[4];
#pragma unroll
    for (int q = 0; q < 4; ++q) { sg[q] = (x[4 * q] + x[4 * q + 1]) + (x[4 * q + 2] + x[4 * q + 3]); sp[q] = __shfl_xor(sg[q], 32); }
    float above = 0.f;
#pragma unroll
    for (int q = 3; q >= 0; --q) {
        const float Tq = above + (hh == 0 ? sp[q] : 0.f);
        const float e2 = x[4 * q + 3], e1 = e2 + x[4 * q + 2], e0 = e1 + x[4 * q + 1], base = C + Tq;
        a[4 * q + 3] = val[4 * q + 3] ? __builtin_amdgcn_exp2f((lsv[4 * q + 3] + base) * LOG2E) : 0.f;
        a[4 * q + 2] = val[4 * q + 2] ? __builtin_amdgcn_exp2f((lsv[4 * q + 2] + base + e2) * LOG2E) : 0.f;
        a[4 * q + 1] = val[4 * q + 1] ? __builtin_amdgcn_exp2f((lsv[4 * q + 1] + base + e1) * LOG2E) : 0.f;
        a[4 * q + 0] = val[4 * q + 0] ? __builtin_amdgcn_exp2f((lsv[4 * q + 0] + base + e0) * LOG2E) : 0.f;
        above += sg[q] + sp[q];
    }
    C += above;
}
__device__ __forceinline__ void sb_unit(Frame& F, int b, int h, int rb) {
    const int lane = F.lane, r = lane & 31, hh = lane >> 5, r0 = rb * 32, i = r0 + r;
    LAS unsigned char* Vst = F.lds + RING_OFF + F.wave * 8192;
    bf16x8 qr[4];
    { const bf16* qp = F.QS + (size_t)(b * T + i) * 512 + h * 64 + hh * 8;
#pragma unroll
      for (int d0 = 0; d0 < 4; ++d0) qr[d0] = *(const bf16x8*)(qp + 16 * d0); }
    f32x16 o[2]; o[0] = f32x16{}; o[1] = f32x16{};
    float C = 0.f;
    const int vlane = ((lane >> 4) & 1) * 32 + (lane & 3) * 8 + (4 * hh + ((lane & 15) >> 2)) * 64;
    for (int t = r0 >> 6; t >= -1; --t) {
        const bf16* kt = t < 0 ? F.KSM + h * 4096 : F.KS + (size_t)((b * 8 + h) * 128 + t) * 4096;
        const bf16* vt = t < 0 ? F.VSM + h * 4096 : F.VS + (size_t)((b * 8 + h) * 128 + t) * 4096;
        asm volatile("s_waitcnt lgkmcnt(0)" ::: "memory");
#pragma unroll
        for (int p = 0; p < 8; ++p) glds16(vt + p * 512 + lane * 8, Vst + p * 1024);
        f32x16 z0 = f32x16{}, z1 = f32x16{};
#pragma unroll
        for (int d0 = 0; d0 < 4; ++d0) {
            const bf16x8 a0 = *(const bf16x8*)(kt + (2 * d0 + hh) * 512 + r * 8), a1 = *(const bf16x8*)(kt + (2 * d0 + hh) * 512 + 256 + r * 8);
            z0 = __builtin_amdgcn_mfma_f32_32x32x16_bf16(a0, qr[d0], z0, 0, 0, 0);
            z1 = __builtin_amdgcn_mfma_f32_32x32x16_bf16(a1, qr[d0], z1, 0, 0, 0);
        }
        f32x16 a0v, a1v;
        sb_scan_block(z1, 32, t, i, hh, C, a1v);
        sb_scan_block(z0, 0, t, i, hh, C, a0v);
        bf16x8 pa[4]; pa[0] = pack8(a0v, 0); pa[1] = pack8(a0v, 8); pa[2] = pack8(a1v, 0); pa[3] = pack8(a1v, 8);
        asm volatile("s_waitcnt vmcnt(0)" ::: "memory");
#pragma unroll
        for (int d = 0; d < 2; ++d)
#pragma unroll
            for (int k = 0; k < 4; ++k) {
                const s16x4 lo = vtr(Vst + vlane + d * 4096 + k * 1024), hi = vtr(Vst + vlane + d * 4096 + k * 1024 + 512);
                const bf16x8 vf = (bf16x8){lo[0], lo[1], lo[2], lo[3], hi[0], hi[1], hi[2], hi[3]};
                o[d] = __builtin_amdgcn_mfma_f32_32x32x16_bf16(vf, pa[k], o[d], 0, 0, 0);
            }
        if (__all(C <= -104.f)) break;
    }
    float ss = 0.f;
#pragma unroll
    for (int d = 0; d < 2; ++d)
#pragma unroll
        for (int g = 0; g < 16; ++g) ss += o[d][g] * o[d][g];
    ss += __shfl_xor(ss, 32);
    const float rn = 1.f / sqrtf(ss * (1.f / 64.f) + EPS);
    const LAS float* sn = (const LAS float*)(F.lds + RING_OFF + L_SN);
    bf16* op = F.MIX + (size_t)(b * T + i) * D + 512 + h * 64 + 4 * hh;
#pragma unroll
    for (int d = 0; d < 2; ++d)
#pragma unroll
        for (int g4 = 0; g4 < 4; ++g4) { const f32x4 gn = *(const LAS f32x4*)(sn + d * 32 + 8 * g4 + 4 * hh);
            v2u pk; pk.x = cvtpk(o[d][4 * g4] * rn * gn.x, o[d][4 * g4 + 1] * rn * gn.y); pk.y = cvtpk(o[d][4 * g4 + 2] * rn * gn.z, o[d][4 * g4 + 3] * rn * gn.w);
            *(v2u*)(op + d * 32 + 8 * g4) = pk; }
    asm volatile("s_waitcnt lgkmcnt(0)" ::: "memory");
}
__device__ __forceinline__ void p2_attention(Frame& F) {
    p2_tables(F);
    float s1 = 0.f, s2 = 0.f;
    for (int d = 0; d < 64; ++d) { s1 += F.lq1[d] * F.lk1[d]; s2 += F.lq2[d] * F.lk2[d]; }
    const float lam = __expf(s1) - __expf(s2) + LAMBDA_INIT;
    __syncthreads();
    for (int u = F.vcu * NWAVES + F.wave; u < NB * 8 * 256; u += F.G * NWAVES) sb_unit(F, u >> 11, (u >> 8) & 7, u & 255);
    __syncthreads();
    for (int v = F.vcu; v < 256; v += F.G) { const int bh = v >> 5, p = v & 31; diff_unit(F, bh >> 2, bh & 3, p, lam); diff_unit(F, bh >> 2, bh & 3, 63 - p, lam); }
}
}

struct NaiveArgs { const bf16 *QD, *KD, *VD, *KDM, *VDM, *QS, *KS, *VS, *KSM, *VSM; bf16* MIX; const float *rel_table, *diff_norm, *sb_norm, *lq1, *lk1, *lq2, *lk2; };
__global__ void __launch_bounds__(64) naive_diff(NaiveArgs a) {
    const int blk = blockIdx.x, bh = blk >> 7, b = bh >> 2, h = bh & 3, c = blk & 127, lane = threadIdx.x, i = c * 64 + lane, row = b * T + i;
    float s1 = 0.f, s2 = 0.f;
    for (int d = 0; d < 64; ++d) { s1 += a.lq1[d] * a.lk1[d]; s2 += a.lq2[d] * a.lk2[d]; }
    const float lam = __expf(s1) - __expf(s2) + LAMBDA_INIT;
    float res[128];
#pragma unroll
    for (int d = 0; d < 128; ++d) res[d] = 0.f;
    for (int s = 0; s < 2; ++s) {
        float q[64];
        const bf16* qp = a.QD + (size_t)row * 512 + h * 128 + s * 64;
#pragma unroll
        for (int d = 0; d < 64; ++d) q[d] = bf2f(qp[d]);
        float o[128];
#pragma unroll
        for (int d = 0; d < 128; ++d) o[d] = 0.f;
        float mx = -1.0e30f, l = 0.f;
        for (int t = -1; t <= c; ++t) {
            const bf16* kt = t < 0 ? a.KDM + (h * 2 + s) * 4096 : a.KD + (size_t)(((b * 4 + h) * 2 + s) * 128 + t) * 4096;
            const bf16* vt = t < 0 ? a.VDM + h * 8192 : a.VD + (size_t)((b * 4 + h) * 128 + t) * 8192;
            const int nb = t < 0 ? 1 : 4;
            for (int kb = 0; kb < nb; ++kb) {
                float sc[16]; float bm = -1.0e30f;
#pragma unroll
                for (int kk = 0; kk < 16; ++kk) { const int key = kb * 16 + kk; float acc = 0.f;
#pragma unroll
                    for (int ch = 0; ch < 8; ++ch) { const v4u kv = *(const v4u*)(kt + ch * 512 + key * 8);
                        acc += q[ch * 8 + 0] * bf2f((unsigned short)(kv.x & 0xffff)) + q[ch * 8 + 1] * bf2f((unsigned short)(kv.x >> 16)) + q[ch * 8 + 2] * bf2f((unsigned short)(kv.y & 0xffff)) + q[ch * 8 + 3] * bf2f((unsigned short)(kv.y >> 16))
                             + q[ch * 8 + 4] * bf2f((unsigned short)(kv.z & 0xffff)) + q[ch * 8 + 5] * bf2f((unsigned short)(kv.z >> 16)) + q[ch * 8 + 6] * bf2f((unsigned short)(kv.w & 0xffff)) + q[ch * 8 + 7] * bf2f((unsigned short)(kv.w >> 16)); }
                    const int rel = t < 0 ? (key - 16 - i) : (t * 64 + key - i);
                    acc += a.rel_table[t5_bucket(rel) * 4 + h] * LOG2E;
                    sc[kk] = acc; bm = fmaxf(bm, acc); }
                const float mn = fmaxf(mx, bm), al = __builtin_amdgcn_exp2f(mx - mn); mx = mn; l *= al;
#pragma unroll
                for (int d = 0; d < 128; ++d) o[d] *= al;
#pragma unroll
                for (int kk = 0; kk < 16; ++kk) { const int key = kb * 16 + kk; const float p = __builtin_amdgcn_exp2f(sc[kk] - mn); l += p;
#pragma unroll
                    for (int db = 0; db < 4; ++db)
#pragma unroll
                        for (int q4 = 0; q4 < 4; ++q4) { const v4u vv = *(const v4u*)(vt + db * 2048 + key * 32 + q4 * 8); const int d0 = db * 32 + q4 * 8;
                            o[d0 + 0] += p * bf2f((unsigned short)(vv.x & 0xffff)); o[d0 + 1] += p * bf2f((unsigned short)(vv.x >> 16)); o[d0 + 2] += p * bf2f((unsigned short)(vv.y & 0xffff)); o[d0 + 3] += p * bf2f((unsigned short)(vv.y >> 16));
                            o[d0 + 4] += p * bf2f((unsigned short)(vv.z & 0xffff)); o[d0 + 5] += p * bf2f((unsigned short)(vv.z >> 16)); o[d0 + 6] += p * bf2f((unsigned short)(vv.w & 0xffff)); o[d0 + 7] += p * bf2f((unsigned short)(vv.w >> 16)); } }
            }
        }
        const float f = (s == 0 ? 1.f : -lam) / l;
#pragma unroll
        for (int d = 0; d < 128; ++d) res[d] += f * o[d];
    }
    float ss = 0.f;
#pragma unroll
    for (int d = 0; d < 128; ++d) ss += res[d] * res[d];
    const float r = (1.f - LAMBDA_INIT) / sqrtf(ss * (1.f / 128.f) + EPS);
    bf16* op = a.MIX + (size_t)row * D + h * 128;
#pragma unroll
    for (int d = 0; d < 128; ++d) op[d] = (bf16)f2bf(res[d] * r * a.diff_norm[d]);
}
__global__ void __launch_bounds__(64) naive_sb(NaiveArgs a) {
    const int blk = blockIdx.x, bh = blk >> 7, b = bh >> 3, h = bh & 7, c = blk & 127, lane = threadIdx.x, i = c * 64 + lane, row = b * T + i;
    float q[64], o[64];
    const bf16* qp = a.QS + (size_t)row * 512 + h * 64;
#pragma unroll
    for (int d = 0; d < 64; ++d) { q[d] = bf2f(qp[d]); o[d] = 0.f; }
    float cum = 0.f;
    for (int t = c; t >= -1; --t) {
        const bf16* kt = t < 0 ? a.KSM + h * 4096 : a.KS + (size_t)((b * 8 + h) * 128 + t) * 4096;
        const bf16* vt = t < 0 ? a.VSM + h * 4096 : a.VS + (size_t)((b * 8 + h) * 128 + t) * 4096;
        for (int key = (t < 0 ? 15 : 63); key >= 0; --key) {
            float z = 0.f;
#pragma unroll
            for (int ch = 0; ch < 8; ++ch) { const v4u kv = *(const v4u*)(kt + ch * 512 + key * 8);
                z += q[ch * 8 + 0] * bf2f((unsigned short)(kv.x & 0xffff)) + q[ch * 8 + 1] * bf2f((unsigned short)(kv.x >> 16)) + q[ch * 8 + 2] * bf2f((unsigned short)(kv.y & 0xffff)) + q[ch * 8 + 3] * bf2f((unsigned short)(kv.y >> 16))
                   + q[ch * 8 + 4] * bf2f((unsigned short)(kv.z & 0xffff)) + q[ch * 8 + 5] * bf2f((unsigned short)(kv.z >> 16)) + q[ch * 8 + 6] * bf2f((unsigned short)(kv.w & 0xffff)) + q[ch * 8 + 7] * bf2f((unsigned short)(kv.w >> 16)); }
            const bool valid = t < 0 || (t * 64 + key) < i;
            const float ls = fminf(z, 0.f) - __logf(1.f + __expf(-fabsf(z)));
            const float lk = ls - z;
            const float w = valid ? __expf(ls + cum) : 0.f;
            cum += valid ? lk : 0.f;
#pragma unroll
            for (int db = 0; db < 2; ++db)
#pragma unroll
                for (int q4 = 0; q4 < 4; ++q4) { const v4u vv = *(const v4u*)(vt + db * 2048 + key * 32 + q4 * 8); const int d0 = db * 32 + q4 * 8;
                    o[d0 + 0] += w * bf2f((unsigned short)(vv.x & 0xffff)); o[d0 + 1] += w * bf2f((unsigned short)(vv.x >> 16)); o[d0 + 2] += w * bf2f((unsigned short)(vv.y & 0xffff)); o[d0 + 3] += w * bf2f((unsigned short)(vv.y >> 16));
                    o[d0 + 4] += w * bf2f((unsigned short)(vv.z & 0xffff)); o[d0 + 5] += w * bf2f((unsigned short)(vv.z >> 16)); o[d0 + 6] += w * bf2f((unsigned short)(vv.w & 0xffff)); o[d0 + 7] += w * bf2f((unsigned short)(vv.w >> 16)); }
        }
    }
    float ss = 0.f;
#pragma unroll
    for (int d = 0; d < 64; ++d) ss += o[d] * o[d];
    const float r = 1.f / sqrtf(ss * (1.f / 64.f) + EPS);
    bf16* op = a.MIX + (size_t)row * D + 512 + h * 64;
#pragma unroll
    for (int d = 0; d < 64; ++d) op[d] = (bf16)f2bf(o[d] * r * a.sb_norm[d]);
}

struct Args { const float* in[19]; float* out; unsigned char* ws; int ph_lo, ph_hi; };
constexpr int NPHASE = 8;
__global__ void __launch_bounds__(NWAVES * 64, 2) fwd(Args args) {
    extern __shared__ __attribute__((aligned(16))) unsigned char lds[];
    Frame F;
    F.lds = (LAS unsigned char*)lds;
    F.MISC = (volatile LAS unsigned*)(F.lds + MISC_OFF);
    F.tid = threadIdx.x; F.lane = F.tid & 63; F.wave = __builtin_amdgcn_readfirstlane(F.tid >> 6);
    F.G = gridDim.x; { const int bx = blockIdx.x; F.vcu = (F.G % 8 == 0) ? (bx % 8) * (F.G / 8) + bx / 8 : bx; }
    unsigned char* ws = args.ws;
    F.ctl = (gu32*)(ws + WS_CTL);
    F.x = args.in[0]; F.meta = args.in[1]; F.rel_table = args.in[2]; F.attn_norm = args.in[3]; F.w_in = args.in[4]; F.lq1 = args.in[5]; F.lk1 = args.in[6]; F.lq2 = args.in[7]; F.lk2 = args.in[8];
    F.diff_norm = args.in[9]; F.sb_norm = args.in[10]; F.w_out = args.in[11]; F.ffn_norm = args.in[12]; F.w_group = args.in[13]; F.w_router = args.in[14]; F.w_gate = args.in[15]; F.w_up = args.in[16];
    F.w_down = args.in[17]; F.final_norm = args.in[18]; F.out = args.out;
    F.Win_t = (bf16*)(ws + WS_WIN); F.Wout_t = (bf16*)(ws + WS_WOUT); F.Wgu_t = (bf16*)(ws + WS_WGU); F.Wd_t = (bf16*)(ws + WS_WD);
    F.HN = (bf16*)(ws + WS_HN); F.MIX = (bf16*)(ws + WS_HN); F.QD = (bf16*)(ws + WS_QD); F.KD = (bf16*)(ws + WS_KD); F.VD = (bf16*)(ws + WS_VD); F.QS = (bf16*)(ws + WS_QS); F.KS = (bf16*)(ws + WS_KS); F.VS = (bf16*)(ws + WS_VS);
    F.HN2 = (bf16*)(ws + WS_HN2); F.HID = (bf16*)(ws + WS_HID); F.Y = (bf16*)(ws + WS_Y);
    F.KDM = (bf16*)(ws + WS_META); F.VDM = F.KDM + 8 * 4096; F.KSM = F.VDM + 4 * 8192; F.VSM = F.KSM + 8 * 4096;
    F.list = (int*)(ws + WS_LIST); F.toke = (int*)(ws + WS_TOKE); F.tokw = (float*)(ws + WS_TOKW);
    for (int u = F.tid; u < (LDS_BYTES - LDSCTL_OFF) / 4; u += NWAVES * 64) ((LAS unsigned*)(F.lds + LDSCTL_OFF))[u] = 0u;
    __syncthreads();
    XcdBarrier bar = xcd_barrier_post((unsigned*)(F.ctl + CW_BAR), F.MISC + 8);
    const int lo = args.ph_lo, hi = args.ph_hi;
#define IN(k) (lo <= (k) && (k) < hi)
#define BOTH(k) (IN(k) && IN((k) + 1))
#define GRID_BAR() xcd_barrier(bar)
    if (IN(0)) { p0_prologue(F); if (BOTH(0)) GRID_BAR(); }
    if (IN(1)) {
        pg8::Gemm g{F.HN, F.Win_t, M, NPROJ, D}; pg8::StaticOrder S; S.init(M, NPROJ, F.G, (int)blockIdx.x);
        pg8::EpiProj E{F.QD, F.KD, F.VD, F.QS, F.KS, F.VS, C2};
        pg8::gemm_phase<pg8::EpiProj, pg8::StaticOrder, true, true, false>(F.lds + RING_OFF, g, S, E);
        if (BOTH(1)) GRID_BAR();
    }
    if (IN(2)) { att::p2_attention(F); if (BOTH(2)) GRID_BAR(); }
    if (IN(3)) {
        pg8::Gemm g{F.MIX, F.Wout_t, M, D, D}; pg8::StaticOrder S; S.init(M, D, F.G, (int)blockIdx.x);
        pg8::EpiRes E{F.x, F.out, D};
        pg8::gemm_phase<pg8::EpiRes, pg8::StaticOrder, true, true, false>(F.lds + RING_OFF, g, S, E);
        if (BOTH(3)) GRID_BAR();
    }
    if (IN(4)) { p4_route(F); if (BOTH(4)) GRID_BAR(); }
    if (IN(5)) {
        pg8::Gemm g{F.HN2, F.Wgu_t, M, 1024, D}; pg8::GroupedOrder S; S.init((const unsigned*)(F.ctl + CW_CNT), F.list, F.G, (int)blockIdx.x);
        pg8::EpiSwiGLU E{F.HID};
        pg8::gemm_phase<pg8::EpiSwiGLU, pg8::GroupedOrder, true, true, true>(F.lds + RING_OFF, g, S, E);
        if (BOTH(5)) GRID_BAR();
    }
    if (IN(6)) {
        pg8::Gemm g{F.HID, F.Wd_t, SLOT_ROWS, 1024, DEXP}; pg8::GroupedOrder S; S.init((const unsigned*)(F.ctl + CW_CNT), F.list, F.G, (int)blockIdx.x);
        pg8::EpiY E{F.Y};
        pg8::gemm_phase<pg8::EpiY, pg8::GroupedOrder, true, true, false>(F.lds + RING_OFF, g, S, E);
        if (BOTH(6)) GRID_BAR();
    }
    if (IN(7)) p7_final(F);
#undef IN
#undef BOTH
#undef GRID_BAR
}

#ifndef MK_STAGED
#define MK_STAGED 0
#endif
#ifndef MK_NAIVE
#define MK_NAIVE 0
#endif
extern "C" void kernel_launch(void* const* d_in, const int* in_sizes, int n_in, void* d_out, int out_size, void* d_ws, size_t ws_size, hipStream_t stream) {
    static int grid = 0;
    if (grid == 0) {
        if (n_in != 19 || out_size != M * D || ws_size < WS_END) { fprintf(stderr, "kernel_launch: unexpected shapes (n_in %d, out %d, ws %zu); nothing launched\n", n_in, out_size, ws_size); grid = -1; return; }
        int dev = 0, cus = 0, per_cu = 0;
        if (hipGetDevice(&dev) != hipSuccess || hipDeviceGetAttribute(&cus, hipDeviceAttributeMultiprocessorCount, dev) != hipSuccess) { grid = -1; return; }
        if (hipFuncSetAttribute((const void*)fwd, hipFuncAttributeMaxDynamicSharedMemorySize, LDS_BYTES) != hipSuccess) { fprintf(stderr, "kernel_launch: hipFuncSetAttribute failed\n"); grid = -1; return; }
        if (hipOccupancyMaxActiveBlocksPerMultiprocessor(&per_cu, (const void*)fwd, NWAVES * 64, LDS_BYTES) != hipSuccess || per_cu < 1) fprintf(stderr, "kernel_launch: occupancy query says %d per CU\n", per_cu);
        (void)hipGetLastError();
        grid = cus;
    }
    if (grid < 0) return;
    (void)hipMemsetAsync((char*)d_ws + WS_CTL, 0, CTL_ZERO_BYTES, stream);
    Args a{};
    for (int i = 0; i < 19; ++i) a.in[i] = (const float*)d_in[i];
    a.out = (float*)d_out; a.ws = (unsigned char*)d_ws;
#if MK_STAGED
    unsigned char* ws = (unsigned char*)d_ws;
    NaiveArgs na{};
    na.QD = (const bf16*)(ws + WS_QD); na.KD = (const bf16*)(ws + WS_KD); na.VD = (const bf16*)(ws + WS_VD); na.QS = (const bf16*)(ws + WS_QS); na.KS = (const bf16*)(ws + WS_KS); na.VS = (const bf16*)(ws + WS_VS);
    na.KDM = (const bf16*)(ws + WS_META); na.VDM = na.KDM + 8 * 4096; na.KSM = na.VDM + 4 * 8192; na.VSM = na.KSM + 8 * 4096; na.MIX = (bf16*)(ws + WS_HN);
    na.rel_table = (const float*)d_in[2]; na.diff_norm = (const float*)d_in[9]; na.sb_norm = (const float*)d_in[10]; na.lq1 = (const float*)d_in[5]; na.lk1 = (const float*)d_in[6]; na.lq2 = (const float*)d_in[7]; na.lk2 = (const float*)d_in[8];
    for (int ph = 0; ph < NPHASE; ++ph) {
        if (MK_NAIVE && ph == 2) { hipLaunchKernelGGL(naive_diff, dim3(NB * 4 * 128), dim3(64), 0, stream, na); hipLaunchKernelGGL(naive_sb, dim3(NB * 8 * 128), dim3(64), 0, stream, na); continue; }
        a.ph_lo = ph; a.ph_hi = ph + 1;
        hipLaunchKernelGGL(fwd, dim3(grid), dim3(NWAVES * 64), LDS_BYTES, stream, a);
    }
#else
    a.ph_lo = 0; a.ph_hi = NPHASE;
    hipLaunchKernelGGL(fwd, dim3(grid), dim3(NWAVES * 64), LDS_BYTES, stream, a);
#endif
    const hipError_t le = hipPeekAtLastError();
    if (le != hipSuccess) fprintf(stderr, "kernel_launch: launch failed: %s\n", hipGetErrorName(le));
}
```

```cpp
#include <hip/hip_runtime.h>
#include <cstdio>
#include <cstdint>
namespace pg8 {
#define PG8_LAS __attribute__((address_space(3)))
typedef unsigned short bf16_t;
typedef short bf16x8 __attribute__((ext_vector_type(8)));
typedef float f32x4 __attribute__((ext_vector_type(4)));
typedef unsigned u32x4 __attribute__((ext_vector_type(4)));
constexpr int BM = 256, BK = 64, HALF = 128, HTB = HALF * BK * 2  , STAGE_BYTES = 8 * HTB, NXCD = 8, WGM = 8;

__host__ __device__ __forceinline__ int lds_byte(int r, int c) { const int st = (r >> 4) * 2 + (c >> 5), rr = r & 15, cc = c & 31, ob = rr * 64 + cc * 2; return st * 1024 + (ob ^ (((ob >> 9) & 1) << 5)); }
__host__ __device__ __forceinline__ void stage_rc(int b, int& R, int& C) { const int st = b / 1024, sb = b % 1024, swz = sb ^ (((sb >> 9) & 1) << 5); R = (st >> 1) * 16 + swz / 64; C = (st & 1) * 32 + (swz % 64) / 2; }
__host__ __device__ __forceinline__ int perm32(int rho) { const int n = rho >> 4, i = rho & 15; return 8 * (i >> 2) + 4 * n + (i & 3); }

struct Unit { int pm, pn, e, lt; };
struct Gemm { const bf16_t* A; const bf16_t* Bt; int M, N, K; };

struct StaticOrder {
    int nM, nN, nwg, G, c;
    __host__ __device__ void init(int M, int N, int G_, int c_) { nM = M / BM; nN = N / BM; nwg = nM * nN; G = G_; c = c_; }
    __host__ __device__ bool next(int i, Unit& u) const {
        const long L = (long)i * G + c; if (L >= nwg) return false;
        int wgid = (int)L; { const int q = nwg / NXCD, r = nwg % NXCD, xcd = wgid % NXCD, off = wgid / NXCD; wgid = (xcd < r ? xcd * (q + 1) : r * (q + 1) + (xcd - r) * q) + off; }
        const int nig = WGM * nN, gid = wgid / nig, fm = gid * WGM, gsz = (nM - fm) < WGM ? (nM - fm) : WGM;
        u.pm = fm + ((wgid % nig) % gsz); u.pn = (wgid % nig) / gsz; u.e = 0; u.lt = 0; return true;
    }
    __device__ __forceinline__ void a_ready(const Unit&) const {}
    __device__ __forceinline__ void done(const Unit&) const {}
};

__device__ __forceinline__ unsigned cvt_pk_bf16(float lo, float hi) { unsigned r; asm volatile("v_cvt_pk_bf16_f32 %0, %1, %2" : "=v"(r) : "v"(lo), "v"(hi)); return r; }
typedef float f32x2 __attribute__((ext_vector_type(2)));

struct EpiProj {
    static constexpr bool PERM = true, AFTER_DRAIN = false;
    bf16_t *Qd, *Kd, *Vd, *Qs, *Ks, *Vs; float c2;
    __device__ __forceinline__ void operator()(const f32x4 (&acc)[2][2][4][2], const Unit& u, int wr, int wc, int fr, int fq) const {
        const int sec = u.pn >> 1;
        const float sc = sec == 0 ? c2 : (sec == 3 ? 0.125f : 1.f);
        const int row0 = u.pm * BM + wr * 64 + fr;
#pragma unroll
        for (int ai = 0; ai < 2; ++ai)
#pragma unroll
            for (int m = 0; m < 4; ++m) {
                const int row = row0 + ai * HALF + m * 16, b = row >> 13, fi = row & 8191, tile = fi >> 6, key = fi & 63;
#pragma unroll
                for (int bj = 0; bj < 2; ++bj) {
                    const int cc = (u.pn & 1) * 256 + bj * HALF + wc * 32 + 8 * fq;
                    const f32x4 v0 = acc[ai][bj][m][0] * sc, v1 = acc[ai][bj][m][1] * sc;
                    u32x4 w; w.x = cvt_pk_bf16(v0[0], v0[1]); w.y = cvt_pk_bf16(v0[2], v0[3]); w.z = cvt_pk_bf16(v1[0], v1[1]); w.w = cvt_pk_bf16(v1[2], v1[3]);
                    bf16_t* p;
                    if (sec == 0) p = Qd + (size_t)row * 512 + cc;
                    else if (sec == 3) p = Qs + (size_t)row * 512 + cc;
                    else if (sec == 1) { const int h = cc >> 7, s = (cc >> 6) & 1, ch = (cc & 63) >> 3; p = Kd + (size_t)(((b * 4 + h) * 2 + s) * 128 + tile) * 4096 + ch * 512 + key * 8; }
                    else if (sec == 2) { const int h = cc >> 7, d = cc & 127; p = Vd + (size_t)((b * 4 + h) * 128 + tile) * 8192 + (d >> 5) * 2048 + key * 32 + (d & 31); }
                    else if (sec == 4) { const int h = cc >> 6, ch = (cc & 63) >> 3; p = Ks + (size_t)((b * 8 + h) * 128 + tile) * 4096 + ch * 512 + key * 8; }
                    else { const int h = cc >> 6, d = cc & 63; p = Vs + (size_t)((b * 8 + h) * 128 + tile) * 4096 + (d >> 5) * 2048 + key * 32 + (d & 31); }
                    *(u32x4*)p = w;
                }
            }
    }
};
struct EpiRes {
    static constexpr bool PERM = false, AFTER_DRAIN = false;
    const float* base; float* out; int ldc;
    __device__ __forceinline__ void operator()(const f32x4 (&acc)[2][2][4][2], const Unit& u, int wr, int wc, int fr, int fq) const {
        const int row0 = u.pm * BM + wr * 64 + fr, col0 = u.pn * BM + wc * 32 + 4 * fq;
#pragma unroll
        for (int ai = 0; ai < 2; ++ai)
#pragma unroll
            for (int m = 0; m < 4; ++m) { const size_t off = (size_t)(row0 + ai * HALF + m * 16) * ldc + col0;
#pragma unroll
                for (int bj = 0; bj < 2; ++bj)
#pragma unroll
                    for (int n = 0; n < 2; ++n) { const f32x4 bs = *(const f32x4*)(base + off + bj * HALF + n * 16); *(f32x4*)(out + off + bj * HALF + n * 16) = bs + acc[ai][bj][m][n]; } }
    }
};
__device__ __forceinline__ float silu_mul(float g, float u) { return g * __builtin_amdgcn_rcpf(1.0f + __builtin_amdgcn_exp2f(-1.4426950408889634f * g)) * u; }
struct EpiSwiGLU {
    static constexpr bool PERM = true, AFTER_DRAIN = false;
    bf16_t* H;
    __device__ __forceinline__ void operator()(const f32x4 (&acc)[2][2][4][2], const Unit& u, int wr, int wc, int fr, int fq) const {
        const int row0 = u.pm * BM + wr * 64 + fr, col0 = (u.pn & 3) * 128 + wc * 32 + 8 * fq;
#pragma unroll
        for (int ai = 0; ai < 2; ++ai)
#pragma unroll
            for (int m = 0; m < 4; ++m) {
                const f32x4 g0 = acc[ai][0][m][0], g1 = acc[ai][0][m][1], u0 = acc[ai][1][m][0], u1 = acc[ai][1][m][1];
                u32x4 w; w.x = cvt_pk_bf16(silu_mul(g0[0], u0[0]), silu_mul(g0[1], u0[1])); w.y = cvt_pk_bf16(silu_mul(g0[2], u0[2]), silu_mul(g0[3], u0[3]));
                w.z = cvt_pk_bf16(silu_mul(g1[0], u1[0]), silu_mul(g1[1], u1[1])); w.w = cvt_pk_bf16(silu_mul(g1[2], u1[2]), silu_mul(g1[3], u1[3]));
                *(u32x4*)(H + (size_t)(row0 + ai * HALF + m * 16) * 512 + col0) = w;
            }
    }
};
struct EpiY {
    static constexpr bool PERM = true, AFTER_DRAIN = false;
    bf16_t* Y;
    __device__ __forceinline__ void operator()(const f32x4 (&acc)[2][2][4][2], const Unit& u, int wr, int wc, int fr, int fq) const {
        const int row0 = u.pm * BM + wr * 64 + fr, col0 = (u.pn & 3) * BM + wc * 32 + 8 * fq;
#pragma unroll
        for (int ai = 0; ai < 2; ++ai)
#pragma unroll
            for (int m = 0; m < 4; ++m) { bf16_t* rowp = Y + (size_t)(row0 + ai * HALF + m * 16) * 1024 + col0;
#pragma unroll
                for (int bj = 0; bj < 2; ++bj) { const f32x4 v0 = acc[ai][bj][m][0], v1 = acc[ai][bj][m][1];
                    u32x4 w; w.x = cvt_pk_bf16(v0[0], v0[1]); w.y = cvt_pk_bf16(v0[2], v0[3]); w.z = cvt_pk_bf16(v1[0], v1[1]); w.w = cvt_pk_bf16(v1[2], v1[3]);
                    *(u32x4*)(rowp + bj * HALF) = w; } }
    }
};
struct GroupedOrder {
    int pre[17], cnt[16]; const int* list; int G, c;
    __device__ __forceinline__ void init(const unsigned* gcnt, const int* list_, int G_, int c_) {
        list = list_; G = G_; c = c_; int a = 0;
#pragma unroll
        for (int e = 0; e < 16; ++e) { cnt[e] = __builtin_amdgcn_readfirstlane((int)__hip_atomic_load(gcnt + 64 * e, __ATOMIC_RELAXED, __HIP_MEMORY_SCOPE_AGENT)); pre[e] = a; a += (cnt[e] + 255) >> 8; }
        pre[16] = a;
    }
    __device__ __forceinline__ bool next(int i, Unit& u) const {
        const int L = i * G + c, rt = L >> 2; if (rt >= pre[16]) return false;
        int e = 0, pe = 0;
#pragma unroll
        for (int k = 1; k < 16; ++k) if (rt >= pre[k]) { e = k; pe = pre[k]; }
        u.pm = rt; u.pn = e * 4 + (L & 3); u.e = e; u.lt = rt - pe; return true;
    }
    __device__ __forceinline__ void a_ready(const Unit&) const {}
    __device__ __forceinline__ void done(const Unit&) const {}
    __device__ __forceinline__ void gather(const Unit& u, const int (&RA)[2], const int (&CA)[2], int K, unsigned (&v)[2][2]) const {
        int ce = 1;
#pragma unroll
        for (int k = 0; k < 16; ++k) if (u.e == k) ce = cnt[k];
        const int* lp = list + u.e * 16384;
#pragma unroll
        for (int h = 0; h < 2; ++h)
#pragma unroll
            for (int i = 0; i < 2; ++i) { int pos = u.lt * 256 + h * HALF + RA[i]; pos = pos < ce ? pos : ce - 1; const int tok = lp[pos]; v[h][i] = (unsigned)(tok * K + CA[i]) * 2u; }
#pragma unroll
        for (int h = 0; h < 2; ++h)
#pragma unroll
            for (int i = 0; i < 2; ++i) asm volatile("" : "+v"(v[h][i]) :: "memory");
    }
};
template <class Epi, class Sched, bool ALIGN_EPI = false, bool SP2 = false, bool GATHER = false>
__device__ __forceinline__ void gemm_phase(PG8_LAS unsigned char* lds, const Gemm g, const Sched& S, const Epi& E, int wave_id  ) {
    int lane; asm volatile("v_mbcnt_lo_u32_b32 %0, -1, 0\n\tv_mbcnt_hi_u32_b32 %0, -1, %0" : "=v"(lane));
    const int wid = wave_id, tid = wid * 64 + lane, wr = wid >> 2, wc = wid & 3, fr = lane & 15, fq = lane >> 4;
    const int K = g.K, nt = K / BK;
    unsigned vc[2][2], vn[2][2], voffB[2]; int RA[2], CA[2];
#pragma unroll
    for (int i = 0; i < 2; ++i) { int R, C; stage_rc(tid * 16 + i * 8192, R, C); const int Rb = Epi::PERM ? ((R & ~31) + perm32(R & 31)) : R; RA[i] = R; CA[i] = C;
        vc[0][i] = (unsigned)(R * K + C) * 2u; vc[1][i] = (unsigned)((R + HALF) * K + C) * 2u; vn[0][i] = vc[0][i]; vn[1][i] = vc[1][i]; voffB[i] = (unsigned)(Rb * K + C) * 2u; }
    const size_t kstep = (size_t)(BK * 2);
    const size_t hstep = (size_t)HALF * K * 2;
    const size_t tstep = 2 * hstep;
    const unsigned ldsw = (unsigned)wid * 1024u;
    const int aoff = lds_byte(wr * 64 + fr, fq * 8), boff = lds_byte(wc * 32 + fr, fq * 8);
#define PG8_SA(b, h) (((b) * 2 + (h)) * HTB)
#define PG8_AP(p, h) ((p) + (GATHER ? (size_t)0 : (size_t)(h) * hstep))
#define PG8_AV(X, h) (GATHER ? X[h] : vc[0])
#define PG8_SB(b, h) ((4 + (b) * 2 + (h)) * HTB)
#define PG8_STAGE(bufoff, gbase, voff) do { _Pragma("unroll") for (int _i = 0; _i < 2; ++_i) \
        __builtin_amdgcn_global_load_lds((const unsigned*)((const char*)(gbase) + (voff)[_i]), (PG8_LAS unsigned*)(lds + (bufoff) + ldsw + _i * 8192), 16, 0, 0); } while (0)
#define PG8_LDA(dst, b, h) do { _Pragma("unroll") for (int m = 0; m < 4; ++m) _Pragma("unroll") for (int k = 0; k < 2; ++k) dst[m][k] = *(const PG8_LAS bf16x8*)(lds + PG8_SA(b, h) + aoff + m * 2048 + k * 1024); } while (0)
#define PG8_LDB(dst, b, h) do { _Pragma("unroll") for (int n = 0; n < 2; ++n) _Pragma("unroll") for (int k = 0; k < 2; ++k) dst[n][k] = *(const PG8_LAS bf16x8*)(lds + PG8_SB(b, h) + boff + n * 2048 + k * 1024); } while (0)
#define PG8_MMA(ai, bj, At, Bt) do { __builtin_amdgcn_s_setprio(1); _Pragma("unroll") for (int m = 0; m < 4; ++m) _Pragma("unroll") for (int n = 0; n < 2; ++n) _Pragma("unroll") for (int k = 0; k < 2; ++k) \
        acc[ai][bj][m][n] = __builtin_amdgcn_mfma_f32_16x16x32_bf16(Bt[n][k], At[m][k], acc[ai][bj][m][n], 0, 0, 0); __builtin_amdgcn_s_setprio(0); } while (0)
#define PG8_WAIT_V(n) asm volatile("s_waitcnt vmcnt(" #n ")" ::: "memory")
#define PG8_WAIT_L(n) asm volatile("s_waitcnt lgkmcnt(" #n ")" ::: "memory")
#define PG8_BAR __builtin_amdgcn_s_barrier()
#define PG8_SCHED __builtin_amdgcn_sched_barrier(0)
    Unit cur, nxt; int ui = 0;
    if (!S.next(0, cur)) return;
    f32x4 acc[2][2][4][2];
#pragma unroll
    for (int a = 0; a < 2; ++a)
#pragma unroll
        for (int b = 0; b < 2; ++b)
#pragma unroll
            for (int m = 0; m < 4; ++m)
#pragma unroll
                for (int n = 0; n < 2; ++n) acc[a][b][m][n] = (f32x4){0.f, 0.f, 0.f, 0.f};
    bf16x8 At[4][2], B0[2][2], B1[2][2];
    const char* cA = (const char*)g.A + (GATHER ? (size_t)0 : (size_t)cur.pm * tstep); const char* cB = (const char*)g.Bt + (size_t)cur.pn * tstep;
    if constexpr (GATHER) S.gather(cur, RA, CA, K, vc);
    S.a_ready(cur);
    if constexpr (SP2) {
        PG8_STAGE(PG8_SB(0, 0), cB, voffB); PG8_STAGE(PG8_SB(0, 1), cB + hstep, voffB); PG8_STAGE(PG8_SA(0, 0), PG8_AP(cA, 0), PG8_AV(vc, 0)); PG8_STAGE(PG8_SA(0, 1), PG8_AP(cA, 1), PG8_AV(vc, 1));
        if (wr == 1) PG8_BAR;
        PG8_WAIT_V(2); PG8_BAR;
        PG8_STAGE(PG8_SB(1, 0), cB + kstep, voffB); PG8_STAGE(PG8_SA(1, 0), PG8_AP(cA + kstep, 0), PG8_AV(vc, 0)); PG8_STAGE(PG8_SB(1, 1), cB + hstep + kstep, voffB);
        PG8_WAIT_V(6); PG8_BAR;
    } else {
        PG8_STAGE(PG8_SB(0, 0), cB, voffB); PG8_STAGE(PG8_SA(0, 0), PG8_AP(cA, 0), PG8_AV(vc, 0)); PG8_STAGE(PG8_SB(0, 1), cB + hstep, voffB); PG8_STAGE(PG8_SA(0, 1), PG8_AP(cA, 1), PG8_AV(vc, 1));
        if (wr == 1) PG8_BAR;
        PG8_WAIT_V(4); PG8_BAR;
        PG8_STAGE(PG8_SB(1, 0), cB + kstep, voffB); PG8_STAGE(PG8_SA(1, 0), PG8_AP(cA + kstep, 0), PG8_AV(vc, 0)); PG8_STAGE(PG8_SB(1, 1), cB + hstep + kstep, voffB);
        PG8_WAIT_V(6); PG8_BAR;
    }
    for (;;) {
        const bool has_next = S.next(ui + 1, nxt);
        const char* nA = (has_next && !GATHER) ? (const char*)g.A + (size_t)nxt.pm * tstep : cA; const char* nB = has_next ? (const char*)g.Bt + (size_t)nxt.pn * tstep : cB;
        if constexpr (GATHER) { if (has_next) S.gather(nxt, RA, CA, K, vn); else {
#pragma unroll
            for (int h_ = 0; h_ < 2; ++h_)
#pragma unroll
                for (int i_ = 0; i_ < 2; ++i_) vn[h_][i_] = vc[h_][i_]; } }
        for (int t = 0; t < nt; t += 2) {
            const bool last = (t == nt - 2);
            const char* a1 = cA + (size_t)(t + 1) * kstep;
            const char* a2 = last ? nA : cA + (size_t)(t + 2) * kstep; const char* b2 = last ? nB : cB + (size_t)(t + 2) * kstep;
            const char* a3 = a2 + kstep; const char* b3 = b2 + kstep;
            unsigned s2[2][2];
#pragma unroll
            for (int h_ = 0; h_ < 2; ++h_)
#pragma unroll
                for (int i_ = 0; i_ < 2; ++i_) s2[h_][i_] = (GATHER && last) ? vn[h_][i_] : vc[h_][i_];
            if (last && has_next) S.a_ready(nxt);
            if constexpr (SP2) {
            PG8_LDB(B0, 0, 0); PG8_LDB(B1, 0, 1); PG8_SCHED; PG8_LDA(At, 0, 0); PG8_STAGE(PG8_SA(1, 1), PG8_AP(a1, 1), PG8_AV(vc, 1));
            PG8_WAIT_V(8); PG8_WAIT_L(0); PG8_BAR; PG8_MMA(0, 0, At, B0); PG8_MMA(0, 1, At, B1); PG8_BAR; PG8_SCHED;
            PG8_LDA(At, 0, 1); PG8_STAGE(PG8_SB(0, 0), b2, voffB); PG8_STAGE(PG8_SB(0, 1), b2 + hstep, voffB); PG8_STAGE(PG8_SA(0, 0), PG8_AP(a2, 0), PG8_AV(s2, 0));
            PG8_WAIT_V(8); PG8_WAIT_L(0); PG8_BAR; PG8_MMA(1, 0, At, B0); PG8_MMA(1, 1, At, B1); PG8_BAR; PG8_SCHED;
            PG8_LDB(B0, 1, 0); PG8_LDB(B1, 1, 1); PG8_SCHED; PG8_LDA(At, 1, 0); PG8_STAGE(PG8_SA(0, 1), PG8_AP(a2, 1), PG8_AV(s2, 1));
            PG8_WAIT_V(8); PG8_WAIT_L(0); PG8_BAR; PG8_MMA(0, 0, At, B0); PG8_MMA(0, 1, At, B1); PG8_BAR; PG8_SCHED;
            PG8_LDA(At, 1, 1); PG8_STAGE(PG8_SB(1, 0), b3, voffB); PG8_STAGE(PG8_SB(1, 1), b3 + hstep, voffB); PG8_STAGE(PG8_SA(1, 0), PG8_AP(a3, 0), PG8_AV(s2, 0));
            PG8_WAIT_V(8); PG8_WAIT_L(0); PG8_BAR; PG8_MMA(1, 0, At, B0); PG8_MMA(1, 1, At, B1); PG8_BAR; PG8_SCHED;
            } else {
            PG8_LDB(B0, 0, 0); PG8_SCHED; PG8_LDA(At, 0, 0); PG8_STAGE(PG8_SA(1, 1), PG8_AP(a1, 1), PG8_AV(vc, 1));
            PG8_WAIT_L(8); PG8_BAR; PG8_WAIT_L(0); PG8_MMA(0, 0, At, B0); PG8_BAR; PG8_SCHED;
            PG8_LDB(B1, 0, 1); PG8_STAGE(PG8_SB(0, 0), b2, voffB);
            PG8_BAR; PG8_WAIT_L(0); PG8_MMA(0, 1, At, B1); PG8_BAR;
            PG8_LDA(At, 0, 1); PG8_STAGE(PG8_SA(0, 0), PG8_AP(a2, 0), PG8_AV(s2, 0));
            PG8_BAR; PG8_WAIT_L(0); PG8_MMA(1, 0, At, B0); PG8_BAR; PG8_SCHED;
            PG8_STAGE(PG8_SB(0, 1), b2 + hstep, voffB);
            PG8_WAIT_V(6); PG8_BAR; PG8_MMA(1, 1, At, B1); PG8_BAR;
            PG8_LDB(B0, 1, 0); PG8_SCHED; PG8_LDA(At, 1, 0); PG8_STAGE(PG8_SA(0, 1), PG8_AP(a2, 1), PG8_AV(s2, 1));
            PG8_WAIT_L(8); PG8_BAR; PG8_WAIT_L(0); PG8_MMA(0, 0, At, B0); PG8_BAR; PG8_SCHED;
            PG8_LDB(B1, 1, 1); PG8_STAGE(PG8_SB(1, 0), b3, voffB);
            PG8_BAR; PG8_WAIT_L(0); PG8_MMA(0, 1, At, B1); PG8_BAR;
            PG8_LDA(At, 1, 1); PG8_STAGE(PG8_SA(1, 0), PG8_AP(a3, 0), PG8_AV(s2, 0));
            PG8_BAR; PG8_WAIT_L(0); PG8_MMA(1, 0, At, B0); PG8_BAR; PG8_SCHED;
            PG8_STAGE(PG8_SB(1, 1), b3 + hstep, voffB);
            PG8_WAIT_V(6); PG8_BAR; PG8_MMA(1, 1, At, B1); PG8_BAR;
            }
        }
        if constexpr (ALIGN_EPI) { if (wr == 0) PG8_BAR; }
        if constexpr (!Epi::AFTER_DRAIN) { E(acc, cur, wr, wc, fr, fq); S.done(cur); }
        if (!has_next) break;
#pragma unroll
        for (int a = 0; a < 2; ++a)
#pragma unroll
            for (int b = 0; b < 2; ++b)
#pragma unroll
                for (int m = 0; m < 4; ++m)
#pragma unroll
                    for (int n = 0; n < 2; ++n) acc[a][b][m][n] = (f32x4){0.f, 0.f, 0.f, 0.f};
        cur = nxt; cA = nA; cB = nB; ++ui;
        if constexpr (GATHER) {
#pragma unroll
            for (int h_ = 0; h_ < 2; ++h_)
#pragma unroll
                for (int i_ = 0; i_ < 2; ++i_) vc[h_][i_] = vn[h_][i_]; }
        if constexpr (ALIGN_EPI) { if (wr == 1) PG8_BAR; }
    }
    PG8_WAIT_V(0);
    if constexpr (!ALIGN_EPI) { if (wr == 0) PG8_BAR; }
    PG8_BAR;
    if constexpr (Epi::AFTER_DRAIN) { E.fused(acc, cur, wr, wc, fr, fq, lds, wid, lane); S.done(cur); }
#undef PG8_SA
#undef PG8_AP
#undef PG8_AV
#undef PG8_SB
#undef PG8_STAGE
#undef PG8_LDA
#undef PG8_LDB
#undef PG8_MMA
#undef PG8_WAIT_V
#undef PG8_WAIT_L
#undef PG8_BAR
#undef PG8_SCHED
}
}

constexpr int NB = 2, T = 8192, D = 1024, M = NB * T;
constexpr int NPROJ = 3072, NEXP = 16, DEXP = 512, NMETA = 16;
constexpr float EPS = 1e-6f, LOG2E = 1.4426950408889634f;
constexpr float C2 = 0.125f * LOG2E;
constexpr float LAMBDA_INIT = 0.2f;
constexpr int SLOT_ROWS = 36864;

constexpr size_t MiB = 1u << 20;
constexpr size_t WS_CTL = 0, CTL_ZERO_BYTES = 1 * MiB;
constexpr size_t WS_WIN = 2 * MiB, WS_WOUT = 8 * MiB, WS_WGU = 10 * MiB, WS_WD = 42 * MiB;
constexpr size_t WS_HN = 58 * MiB;
constexpr size_t WS_QD = 90 * MiB, WS_KD = 106 * MiB, WS_VD = 122 * MiB, WS_QS = 138 * MiB, WS_KS = 154 * MiB, WS_VS = 170 * MiB;
constexpr size_t WS_HN2 = 90 * MiB;
constexpr size_t WS_HID = 122 * MiB;
constexpr size_t WS_Y = 158 * MiB;
constexpr size_t WS_META = 232 * MiB;
constexpr size_t WS_LIST = 233 * MiB;
constexpr size_t WS_TOKE = 234 * MiB;
constexpr size_t WS_TOKW = 235 * MiB;
constexpr size_t WS_END = 256 * MiB;
static_assert(WS_HID + (size_t)SLOT_ROWS * 512 * 2 <= WS_Y && WS_Y + (size_t)SLOT_ROWS * 1024 * 2 <= WS_META, "d_ws map");
constexpr int CW_TMO = 0, CW_CNT = 1024  , CW_BAR = 4096;

constexpr int RING_OFF = 0, RING_BYTES = 131072;
constexpr int LDSCTL_OFF = RING_BYTES, MISC_OFF = LDSCTL_OFF + 320;
constexpr int LDS_BYTES = 147456;
constexpr int NWAVES = 8;

#define GAS __attribute__((address_space(1)))
#define LAS __attribute__((address_space(3)))
typedef unsigned short bf16;
typedef unsigned v4u __attribute__((ext_vector_type(4)));
typedef unsigned v2u __attribute__((ext_vector_type(2)));
typedef float f32x4 __attribute__((ext_vector_type(4)));
typedef short bf16x8 __attribute__((ext_vector_type(8)));
typedef GAS unsigned gu32;
typedef GAS unsigned long long gu64;
#define RLX_AGENT __ATOMIC_RELAXED, __HIP_MEMORY_SCOPE_AGENT
#define LDS_WAIT() asm volatile("s_waitcnt lgkmcnt(0)" ::: "memory")
#define VM_WAIT() asm volatile("s_waitcnt vmcnt(0)" ::: "memory")
__device__ __forceinline__ unsigned f2bf(float f) { unsigned u = __builtin_bit_cast(unsigned, f); return (u + 0x7fffu + ((u >> 16) & 1u)) >> 16; }
__device__ __forceinline__ unsigned pk2(float lo, float hi) { return f2bf(lo) | (f2bf(hi) << 16); }
__device__ __forceinline__ float bf2f(unsigned short h) { return __builtin_bit_cast(float, (unsigned)h << 16); }
#define XB_TMO      128
#define XB_XCNT(j)  (256  + 64 * (j))
#define XB_XSUB(j)  (1280 + 64 * (j))
#define XB_XGEN(j)  (2304 + 64 * (j))
#define XB_TOP      3328
#define XB_TOPGEN   3392
#define XCD_BAR_WORDS 3456
#define XB_SPIN_CAP (1u << 18)

__device__ __forceinline__ unsigned xb_ld(unsigned* p)              { return __hip_atomic_load(p, __ATOMIC_RELAXED, __HIP_MEMORY_SCOPE_AGENT); }
__device__ __forceinline__ unsigned xb_add(unsigned* p, unsigned v) { return __hip_atomic_fetch_add(p, v, __ATOMIC_RELAXED, __HIP_MEMORY_SCOPE_AGENT); }
__device__ __forceinline__ unsigned xb_xcc_id() { return (unsigned)__builtin_amdgcn_s_getreg((3 << 11) | 20) & 0xFu; }
#define XB_SPIN(cond, bar) do { unsigned _sp = 0; while (cond) { __builtin_amdgcn_s_sleep(1); \
    if ((++_sp & 255u) == 0u) { if (xb_ld(&(bar)[XB_TMO])) break; if (_sp > XB_SPIN_CAP) { atomicAdd(&(bar)[XB_TMO], 1u); break; } } } } while (0)

struct XcdBarrier {
    unsigned* bar; unsigned x;
    volatile LAS unsigned* st;
};

__device__ __forceinline__ XcdBarrier xcd_barrier_post(unsigned* bar, volatile LAS unsigned* st, int tid) {
    XcdBarrier b; b.bar = bar; b.x = xb_xcc_id(); b.st = st;
    if (tid == 0) (void)xb_add(&bar[XB_XCNT(b.x)], 1u);
    return b;
}
__device__ __forceinline__ void xcd_barrier_complete(unsigned* bar, unsigned x, unsigned& nloc, unsigned& nx) {
    const unsigned G = gridDim.x * gridDim.y * gridDim.z;
    unsigned sum, cnt, mine, sp = 0u;
    for (;;) {
        sum = 0u; cnt = 0u; mine = 0u;
#pragma unroll
        for (unsigned j = 0; j < 16; ++j) { const unsigned c = xb_ld(&bar[XB_XCNT(j)]); sum += c; cnt += (c > 0u) ? 1u : 0u; mine = (j == x) ? c : mine; }
        if (sum == G) break;
        __builtin_amdgcn_s_sleep(1);
        if ((++sp & 255u) == 0u) { if (xb_ld(&bar[XB_TMO])) break; if (sp > XB_SPIN_CAP) { atomicAdd(&bar[XB_TMO], 1u); break; } }
    }
    nloc = mine > 0u ? mine : 1u; nx = cnt > 0u ? cnt : 1u;
}

__device__ __forceinline__ void xcd_barrier(const XcdBarrier& b, int tid  ) {
    asm volatile("s_waitcnt vmcnt(0)" ::: "memory");
    __syncthreads();
    if (tid == 0) {
        unsigned* bar = b.bar;
        __builtin_amdgcn_s_waitcnt(0);
        unsigned nloc = b.st[0], nx = b.st[1];
        if (nloc == 0u) { xcd_barrier_complete(bar, b.x, nloc, nx); b.st[0] = nloc; b.st[1] = nx; }
        const unsigned old = xb_add(&bar[XB_XSUB(b.x)], 1u);
        const unsigned gen = old / nloc;
        if (old + 1u == (gen + 1u) * nloc) {
            __builtin_amdgcn_fence(__ATOMIC_RELEASE, "agent");
            asm volatile("s_waitcnt vmcnt(0)" ::: "memory");
            const unsigned og = xb_add(&bar[XB_TOP], 1u);
            const unsigned tg = og / nx;
            if (og + 1u == (tg + 1u) * nx) xb_add(&bar[XB_TOPGEN], 1u);
            else XB_SPIN(xb_ld(&bar[XB_TOPGEN]) == tg, bar);
            __builtin_amdgcn_fence(__ATOMIC_ACQUIRE, "agent");
            xb_add(&bar[XB_XGEN(b.x)], 1u);
            asm volatile("s_waitcnt vmcnt(0)" ::: "memory");
        } else {
            XB_SPIN(xb_ld(&bar[XB_XGEN(b.x)]) == gen, bar);
            __builtin_amdgcn_fence(__ATOMIC_ACQUIRE, "agent");
            asm volatile("s_waitcnt vmcnt(0)" ::: "memory");
        }
    }
    __syncthreads();
}

__device__ __forceinline__ int lane_now() { int x; asm volatile("v_mbcnt_lo_u32_b32 %0, -1, 0\n\tv_mbcnt_hi_u32_b32 %0, -1, %0" : "=v"(x)); return x; }
#define LANE_TID(F) const int lane_ = lane_now(), tid_ = (F).wave * 64 + lane_; (void)tid_
struct Frame {
    LAS unsigned char* lds;
    volatile LAS unsigned* MISC;
    gu32* ctl;
    int wave, vcu, G;
    const float *x, *meta, *rel_table, *attn_norm, *w_in, *lq1, *lk1, *lq2, *lk2, *diff_norm, *sb_norm, *w_out, *ffn_norm, *w_group, *w_router, *w_gate, *w_up, *w_down, *final_norm;
    float* out;
    bf16 *Win_t, *Wout_t, *Wgu_t, *Wd_t;
    bf16 *HN, *MIX, *QD, *KD, *VD, *QS, *KS, *VS, *HN2, *HID, *Y, *KDM, *VDM, *KSM, *VSM;
    int* list; int* toke; float* tokw;
};

__device__ __forceinline__ float wave_sum(float v) {
#pragma unroll
    for (int o = 1; o < 64; o <<= 1) v += __shfl_xor(v, o);
    return v;
}
__device__ __forceinline__ void p0_transpose_item(const float* W, int K, int N, bf16* WT, int drow0, LAS float* scr, int k0, int n0, int lane) {
#pragma unroll 8
    for (int i = 0; i < 32; ++i) { const int kk = 2 * i + (lane >> 5); scr[kk * 33 + (lane & 31)] = W[(size_t)(k0 + kk) * N + n0 + (lane & 31)]; }
    LDS_WAIT(); asm volatile("" ::: "memory");
    const int c = lane & 7;
#pragma unroll
    for (int j = 0; j < 4; ++j) { const int n = (lane >> 3) + 8 * j; const LAS float* s = scr + (8 * c) * 33 + n;
        v4u o; o.x = pk2(s[0 * 33], s[1 * 33]); o.y = pk2(s[2 * 33], s[3 * 33]); o.z = pk2(s[4 * 33], s[5 * 33]); o.w = pk2(s[6 * 33], s[7 * 33]);
        *(GAS v4u*)(WT + (size_t)(drow0 + n) * K + k0 + 8 * c) = o; }
    LDS_WAIT(); asm volatile("" ::: "memory");
}
__device__ __forceinline__ void rms_row_to_bf16(int lane, const float* xrow, const float* gain, bf16* orow) {
    const GAS f32x4* xr = (const GAS f32x4*)xrow + lane; const GAS f32x4* gr = (const GAS f32x4*)gain + lane;
    f32x4 v[4]; float s = 0.f;
#pragma unroll
    for (int j = 0; j < 4; ++j) { v[j] = xr[64 * j]; s += (v[j].x * v[j].x + v[j].y * v[j].y) + (v[j].z * v[j].z + v[j].w * v[j].w); }
    const float rstd = 1.f / sqrtf(wave_sum(s) * (1.f / D) + EPS);
    GAS unsigned long long* o8 = (GAS unsigned long long*)orow + lane;
#pragma unroll
    for (int j = 0; j < 4; ++j) { const f32x4 g = gr[64 * j]; o8[64 * j] = (unsigned long long)pk2(v[j].x * rstd * g.x, v[j].y * rstd * g.y) | ((unsigned long long)pk2(v[j].z * rstd * g.z, v[j].w * rstd * g.w) << 32); }
}
__device__ __forceinline__ bf16* meta_addr(Frame& F, int col, int key) {
    const int sec = col >> 9, cc = col & 511;
    if (sec == 1) { const int h = cc >> 7, s = (cc >> 6) & 1, ch = (cc & 63) >> 3; return F.KDM + (h * 2 + s) * 4096 + ch * 512 + key * 8 + (cc & 7); }
    if (sec == 2) { const int h = cc >> 7, d = cc & 127; return F.VDM + h * 8192 + (d >> 5) * 2048 + key * 32 + (d & 31); }
    if (sec == 4) { const int h = cc >> 6, ch = (cc & 63) >> 3; return F.KSM + h * 4096 + ch * 512 + key * 8 + (cc & 7); }
    if (sec == 5) { const int h = cc >> 6, d = cc & 63; return F.VSM + h * 4096 + (d >> 5) * 2048 + key * 32 + (d & 31); }
    return nullptr;
}
__device__ __forceinline__ void p0_prologue(Frame& F) {
    LANE_TID(F);
    const int gw = F.vcu * NWAVES + F.wave, NGW = F.G * NWAVES;
    for (int it = blockIdx.x; it < 32; it += F.G) {
        const int sec = it >> 3, sub = it & 7;
        const int colbase = (sec == 0 ? 512 : sec == 1 ? 1024 : sec == 2 ? 2048 : 2560) + sub * 64;
        LAS float* hnm = (LAS float*)(F.lds + RING_OFF);
        LAS float* red = (LAS float*)(F.lds + RING_OFF + 65536);
        for (int r = F.wave * 2; r < F.wave * 2 + 2; ++r) {
            const GAS f32x4* xr = (const GAS f32x4*)(F.meta + (size_t)r * D) + lane_; const GAS f32x4* gr = (const GAS f32x4*)F.attn_norm + lane_;
            f32x4 v[4]; float s = 0.f;
#pragma unroll
            for (int j = 0; j < 4; ++j) { v[j] = xr[64 * j]; s += (v[j].x * v[j].x + v[j].y * v[j].y) + (v[j].z * v[j].z + v[j].w * v[j].w); }
            const float rstd = 1.f / sqrtf(wave_sum(s) * (1.f / D) + EPS);
#pragma unroll
            for (int j = 0; j < 4; ++j) { const f32x4 g = gr[64 * j]; *(LAS f32x4*)(hnm + r * D + 256 * j + 4 * lane_) = v[j] * rstd * g; }
        }
        __syncthreads();
        float acc[16];
#pragma unroll
        for (int m = 0; m < 16; ++m) acc[m] = 0.f;
        const float* wp = F.w_in + (size_t)(F.wave * 128) * NPROJ + colbase + lane_;
        for (int k = 0; k < 128; k += 4) {
            const float w0 = wp[(size_t)(k + 0) * NPROJ], w1 = wp[(size_t)(k + 1) * NPROJ], w2 = wp[(size_t)(k + 2) * NPROJ], w3 = wp[(size_t)(k + 3) * NPROJ];
#pragma unroll
            for (int m = 0; m < 16; ++m) { const f32x4 h4 = *(const LAS f32x4*)(hnm + m * D + F.wave * 128 + k); acc[m] += (h4.x * w0 + h4.y * w1) + (h4.z * w2 + h4.w * w3); }
        }
#pragma unroll
        for (int m = 0; m < 16; ++m) red[(F.wave * 16 + m) * 64 + lane_] = acc[m];
        __syncthreads();
        for (int idx = tid_; idx < 1024; idx += NWAVES * 64) { const int m = idx >> 6, c = idx & 63; float s = 0.f;
#pragma unroll
            for (int w = 0; w < 8; ++w) s += red[(w * 16 + m) * 64 + c];
            *meta_addr(F, colbase + c, m) = (bf16)f2bf(s); }
        for (int idx = tid_; idx < 48 * 64; idx += NWAVES * 64) { const int key = 16 + (idx >> 6), c = idx & 63; *meta_addr(F, colbase + c, key) = (bf16)0; }
        __syncthreads();
    }
    LAS float* scr = (LAS float*)(F.lds + RING_OFF + F.wave * 16384);
    constexpr int I_IN = 16 * 96, I_OUT = 16 * 32, I_G = 16 * 256, I_D = 16 * 256, NITEMS = I_IN + I_OUT + 2 * I_G + I_D;
    for (int it = gw; it < NITEMS; it += NGW) {
        int r = it;
        if (r < I_IN) { p0_transpose_item(F.w_in, D, NPROJ, F.Win_t, 32 * (r % 96), scr, 64 * (r / 96), 32 * (r % 96), lane_); continue; } r -= I_IN;
        if (r < I_OUT) { p0_transpose_item(F.w_out, D, D, F.Wout_t, 32 * (r % 32), scr, 64 * (r / 32), 32 * (r % 32), lane_); continue; } r -= I_OUT;
        if (r < 2 * I_G) { const int up = r >= I_G; if (up) r -= I_G; const int e = r >> 8, q = r & 255, n0 = 32 * (q % 16), k0 = 64 * (q / 16);
            p0_transpose_item((up ? F.w_up : F.w_gate) + (size_t)e * D * DEXP, D, DEXP, F.Wgu_t + (size_t)e * 1024 * D, (n0 >> 7) * 256 + up * 128 + (n0 & 127), scr, k0, n0, lane_); continue; } r -= 2 * I_G;
        { const int e = r >> 8, q = r & 255, n0 = 32 * (q % 32), k0 = 64 * (q / 32);
            p0_transpose_item(F.w_down + (size_t)e * DEXP * D, DEXP, D, F.Wd_t + (size_t)e * D * DEXP, n0, scr, k0, n0, lane_); }
    }
    for (int m = gw; m < M; m += NGW) rms_row_to_bf16(lane_, F.x + (size_t)m * D, F.attn_norm, F.HN + (size_t)m * D);
}

__device__ __forceinline__ void p4_route(Frame& F) {
    LANE_TID(F);
    LAS float* wl = (LAS float*)(F.lds + RING_OFF);
    LAS int* lcnt = (LAS int*)(F.lds + RING_OFF + 81920);
    LAS int* lbase = lcnt + 16;
    LAS int* rinfo = lcnt + 64;
    LAS float* rw = (LAS float*)(rinfo + 256);
    for (int idx = tid_; idx < 1024 * 20; idx += NWAVES * 64) { const int k = idx / 20, o = idx % 20; wl[idx] = o < 4 ? F.w_group[k * 4 + o] : F.w_router[k * 16 + (o - 4)]; }
    const GAS f32x4* gr = (const GAS f32x4*)F.ffn_norm + lane_;
    f32x4 g[4];
#pragma unroll
    for (int j = 0; j < 4; ++j) g[j] = gr[64 * j];
    for (int blk = blockIdx.x; blk < M / 64; blk += F.G) {
        if (tid_ < 16) lcnt[tid_] = 0;
        __syncthreads();
        for (int r = 0; r < 8; ++r) {
            const int lr = F.wave * 8 + r, m = blk * 64 + lr;
            const GAS f32x4* xr = (const GAS f32x4*)(F.out + (size_t)m * D) + lane_;
            f32x4 v[4]; float s = 0.f;
#pragma unroll
            for (int j = 0; j < 4; ++j) { v[j] = xr[64 * j]; s += (v[j].x * v[j].x + v[j].y * v[j].y) + (v[j].z * v[j].z + v[j].w * v[j].w); }
            const float rstd = 1.f / sqrtf(wave_sum(s) * (1.f / D) + EPS);
            GAS unsigned long long* o8 = (GAS unsigned long long*)(F.HN2 + (size_t)m * D) + lane_;
            float lg[20];
#pragma unroll
            for (int o = 0; o < 20; ++o) lg[o] = 0.f;
#pragma unroll
            for (int j = 0; j < 4; ++j) { v[j] = v[j] * rstd * g[j];
                o8[64 * j] = (unsigned long long)pk2(v[j].x, v[j].y) | ((unsigned long long)pk2(v[j].z, v[j].w) << 32);
#pragma unroll
                for (int e = 0; e < 4; ++e) { const LAS f32x4* wp = (const LAS f32x4*)(wl + (256 * j + 4 * lane_ + e) * 20); const float xv = v[j][e];
#pragma unroll
                    for (int q = 0; q < 5; ++q) { const f32x4 w4 = wp[q]; lg[4 * q + 0] += xv * w4.x; lg[4 * q + 1] += xv * w4.y; lg[4 * q + 2] += xv * w4.z; lg[4 * q + 3] += xv * w4.w; } } }
#pragma unroll
            for (int o = 0; o < 20; ++o) lg[o] = wave_sum(lg[o]);
            int gi = 0; float gm = lg[0];
#pragma unroll
            for (int o = 1; o < 4; ++o) if (lg[o] > gm) { gm = lg[o]; gi = o; }
            float gs = 0.f;
#pragma unroll
            for (int o = 0; o < 4; ++o) gs += __expf(lg[o] - gm);
            const float gw_ = 1.f / gs;
            float el[4];
#pragma unroll
            for (int o = 0; o < 4; ++o) el[o] = gi == 0 ? lg[4 + o] : gi == 1 ? lg[8 + o] : gi == 2 ? lg[12 + o] : lg[16 + o];
            int i1 = 0; float m1 = el[0];
#pragma unroll
            for (int o = 1; o < 4; ++o) if (el[o] > m1) { m1 = el[o]; i1 = o; }
            int i2 = -1; float m2 = -3.0e38f;
#pragma unroll
            for (int o = 0; o < 4; ++o) if (o != i1 && el[o] > m2) { m2 = el[o]; i2 = o; }
            const float w1 = 1.f / (1.f + __expf(m2 - m1)), w2 = 1.f - w1;
            if (lane_ == 0) { const int ea = gi * 4 + i1, eb = gi * 4 + i2;
                rinfo[lr * 4 + 0] = ea; rinfo[lr * 4 + 1] = eb; rinfo[lr * 4 + 2] = __hip_atomic_fetch_add(&lcnt[ea], 1, __ATOMIC_RELAXED, __HIP_MEMORY_SCOPE_WORKGROUP); rinfo[lr * 4 + 3] = __hip_atomic_fetch_add(&lcnt[eb], 1, __ATOMIC_RELAXED, __HIP_MEMORY_SCOPE_WORKGROUP);
                rw[lr * 2 + 0] = gw_ * w1; rw[lr * 2 + 1] = gw_ * w2; }
        }
        __syncthreads();
        if (tid_ < 16) lbase[tid_] = (int)__hip_atomic_fetch_add((unsigned*)(F.ctl + CW_CNT + 64 * tid_), (unsigned)lcnt[tid_], RLX_AGENT);
        __syncthreads();
        if (tid_ < 64) { const int lr = tid_, m = blk * 64 + lr; const int ea = rinfo[lr * 4 + 0], eb = rinfo[lr * 4 + 1];
            const int pa = lbase[ea] + rinfo[lr * 4 + 2], pb = lbase[eb] + rinfo[lr * 4 + 3];
            F.list[ea * 16384 + pa] = m; F.list[eb * 16384 + pb] = m;
            F.toke[m * 2 + 0] = ea * 16384 + pa; F.toke[m * 2 + 1] = eb * 16384 + pb; F.tokw[m * 2 + 0] = rw[lr * 2 + 0]; F.tokw[m * 2 + 1] = rw[lr * 2 + 1]; }
        __syncthreads();
    }
}
__device__ __forceinline__ void p7_final(Frame& F) {
    LANE_TID(F);
    LAS int* pre = (LAS int*)(F.lds + RING_OFF);
    if (tid_ == 0) { int a = 0; for (int e = 0; e < 16; ++e) { pre[e] = a * 256; a += ((int)__hip_atomic_load(F.ctl + CW_CNT + 64 * e, RLX_AGENT) + 255) >> 8; } }
    __syncthreads();
    const int gw = F.vcu * NWAVES + F.wave, NGW = F.G * NWAVES;
    const GAS f32x4* gr = (const GAS f32x4*)F.final_norm + lane_;
    f32x4 g[4];
#pragma unroll
    for (int j = 0; j < 4; ++j) g[j] = gr[64 * j];
    for (int m = gw; m < M; m += NGW) {
        const int ta = (int)__hip_atomic_load((GAS unsigned*)F.toke + m * 2 + 0, RLX_AGENT), tb = (int)__hip_atomic_load((GAS unsigned*)F.toke + m * 2 + 1, RLX_AGENT);
        const float wa = __uint_as_float(__hip_atomic_load((GAS unsigned*)F.tokw + m * 2 + 0, RLX_AGENT)), wb = __uint_as_float(__hip_atomic_load((GAS unsigned*)F.tokw + m * 2 + 1, RLX_AGENT));
        const int sa = pre[ta >> 14] + (ta & 16383), sb = pre[tb >> 14] + (tb & 16383);
        GAS f32x4* xr = (GAS f32x4*)(F.out + (size_t)m * D) + lane_;
        const GAS v2u* ya = (const GAS v2u*)(F.Y + (size_t)sa * D) + lane_; const GAS v2u* yb = (const GAS v2u*)(F.Y + (size_t)sb * D) + lane_;
        f32x4 v[4]; float s = 0.f;
#pragma unroll
        for (int j = 0; j < 4; ++j) { const f32x4 h = xr[64 * j]; const v2u a = ya[64 * j], b = yb[64 * j];
            v[j].x = h.x + wa * bf2f((unsigned short)(a.x & 0xffff)) + wb * bf2f((unsigned short)(b.x & 0xffff));
            v[j].y = h.y + wa * bf2f((unsigned short)(a.x >> 16)) + wb * bf2f((unsigned short)(b.x >> 16));
            v[j].z = h.z + wa * bf2f((unsigned short)(a.y & 0xffff)) + wb * bf2f((unsigned short)(b.y & 0xffff));
            v[j].w = h.w + wa * bf2f((unsigned short)(a.y >> 16)) + wb * bf2f((unsigned short)(b.y >> 16));
            s += (v[j].x * v[j].x + v[j].y * v[j].y) + (v[j].z * v[j].z + v[j].w * v[j].w); }
        const float rstd = 1.f / sqrtf(wave_sum(s) * (1.f / D) + EPS);
#pragma unroll
        for (int j = 0; j < 4; ++j) xr[64 * j] = v[j] * rstd * g[j];
    }
}

__device__ __forceinline__ int t5_bucket(int rel) {
    const int n = rel < 0 ? -rel : rel; int b;
    if (n < 8) b = n; else if (n < 12) b = 8; else if (n < 16) b = 9; else if (n < 23) b = 10; else if (n < 32) b = 11; else if (n < 46) b = 12; else if (n < 64) b = 13; else if (n < 91) b = 14; else b = 15;
    return b + (rel > 0 ? 16 : 0);
}
#ifndef PROBE_DMA_X
#define PROBE_DMA_X 1
#endif
namespace att {
typedef float f32x16 __attribute__((ext_vector_type(16)));
typedef short s16x4 __attribute__((ext_vector_type(4)));
typedef short v4i16_t __attribute__((ext_vector_type(4)));
typedef float f32x2_t __attribute__((ext_vector_type(2))); typedef __bf16 bf16x2_t __attribute__((ext_vector_type(2)));
__device__ __forceinline__ unsigned cvtpk(float lo, float hi) { f32x2_t v = {lo, hi}; bf16x2_t b = __builtin_convertvector(v, bf16x2_t); return __builtin_bit_cast(unsigned, b); }
__device__ __forceinline__ int crow(int r, int hi) { return (r & 3) + 8 * (r >> 2) + 4 * hi; }
__device__ __forceinline__ s16x4 vtr(const LAS unsigned char* p) { return __builtin_bit_cast(s16x4, __builtin_amdgcn_ds_read_tr16_b64_v4i16((LAS v4i16_t*)p)); }
__device__ __forceinline__ void glds16(const void* gsrc, LAS unsigned char* ldst) { __builtin_amdgcn_global_load_lds((const unsigned*)gsrc, (LAS unsigned*)ldst, 16, 0, 0); }
__device__ __forceinline__ void glds16_asm(const void* gsrc, unsigned lds_dst) { unsigned keep;
    asm volatile("s_mov_b32 %0, m0\n\ts_mov_b32 m0, %2\n\ts_nop 0\n\tglobal_load_lds_dwordx4 %1, off\n\ts_mov_b32 m0, %0" : "=&s"(keep) : "v"(gsrc), "s"(lds_dst) : "memory"); }
__device__ __forceinline__ bf16x8 pack8(const f32x16& p, int b) { v4u w; w.x = cvtpk(p[b], p[b + 1]); w.y = cvtpk(p[b + 2], p[b + 3]); w.z = cvtpk(p[b + 4], p[b + 5]); w.w = cvtpk(p[b + 6], p[b + 7]); return __builtin_bit_cast(bf16x8, w); }
__device__ __forceinline__ int opaque(int x) { asm volatile("" : "+v"(x)); return x; }
using ::lane_now;
constexpr int L_LUT = 98304, L_DN = 102400, L_SN = 102912;
constexpr float NEG = -1.0e30f;

__device__ __forceinline__ void p2_tables(Frame& F) {
    LANE_TID(F);
    LAS float* lut = (LAS float*)(F.lds + RING_OFF + L_LUT);
    for (int idx = tid_; idx < 1024; idx += NWAVES * 64) { const int h = idx >> 8, rel = (idx & 255) - 191; lut[idx] = F.rel_table[t5_bucket(rel) * 4 + h] * LOG2E; }
    if (tid_ < 128) ((LAS float*)(F.lds + RING_OFF + L_DN))[tid_] = F.diff_norm[tid_];
    if (tid_ < 64) ((LAS float*)(F.lds + RING_OFF + L_SN))[tid_] = F.sb_norm[tid_];
}

__device__ __forceinline__ void rescale_o(f32x16 (&o)[4], float al) {
#pragma unroll
    for (int d = 0; d < 4; ++d)
#pragma unroll
        for (int g = 0; g < 16; ++g) { float x = o[d][g]; asm volatile("v_mul_f32 %0, %0, %1" : "+v"(x) : "v"(al)); o[d][g] = x; }
}
struct DiffState { f32x16 o[4]; f32x16 s0, s1; bf16x8 pp[4]; float mrun, lrun; };
constexpr float DIFF_THR = 6.0f;
#define SBAR() __builtin_amdgcn_sched_barrier(0)
template <bool FAST>
__device__ __forceinline__ void diff_iter(DiffState& st, LAS unsigned char* L, const bf16x8 (&qr)[4], float cfar, int kslot  , int vslot  , int kbase, int lane_,
                                          bool do_qk, bool do_sm, bool do_pv, bool near, bool meta, const LAS float* lpu) {
    float al = 1.f, mn = st.mrun, ls = 0.f;
    int vlane, koff;
    { const int l_ = lane_now(); vlane = ((l_ >> 4) & 1) * 32 + (l_ & 3) * 8 + (4 * (l_ >> 5) + ((l_ & 15) >> 2)) * 64; koff = kbase + (l_ >> 5) * 1024 + (l_ & 31) * 16; }
    f32x16& p0 = st.s0; f32x16& p1 = st.s1;
    const LAS unsigned char* Kb = L + kslot + koff;
    SBAR();
    if (FAST || do_sm) {
        if (!FAST) {
            if (near) {
                const int ln2_ = lane_now(); const LAS float* lp = lpu - (ln2_ & 31) + 4 * (ln2_ >> 5);
#pragma unroll
                for (int g = 0; g < 16; ++g) { p0[g] += lp[(g & 3) + 8 * (g >> 2)] - cfar; p1[g] += lp[32 + (g & 3) + 8 * (g >> 2)] - cfar; }
            }
            if (meta) {
#pragma unroll
                for (int g = 0; g < 16; ++g) { if (g >= 8) p0[g] = NEG; p1[g] = NEG; }
            }
        }
        float rm = fmaxf(p0[0], p1[0]);
#pragma unroll
        for (int g = 1; g < 16; ++g) rm = fmaxf(rm, fmaxf(p0[g], p1[g]));
        rm = fmaxf(rm, __shfl_xor(rm, 32));
        mn = (rm > st.mrun + DIFF_THR) ? rm : st.mrun;
        al = __builtin_amdgcn_exp2f(st.mrun - mn); st.mrun = mn;
    }
#pragma unroll
    for (int k = 0; k < 4; ++k) {
        if (FAST || do_pv) {
            const LAS unsigned char* Vb = L + 49152 + vslot + vlane + k * 1024;
#pragma unroll
            for (int d = 0; d < 4; ++d) {
                const s16x4 lo = vtr(Vb + d * 4096), hi = vtr(Vb + d * 4096 + 512);
                const bf16x8 vf = (bf16x8){lo[0], lo[1], lo[2], lo[3], hi[0], hi[1], hi[2], hi[3]};
                st.o[d] = __builtin_amdgcn_mfma_f32_32x32x16_bf16(vf, st.pp[k], st.o[d], 0, 0, 0);
            }
        }
        if (FAST || do_sm) {
            f32x16& p = (k < 2) ? p0 : p1; const int b8 = (k & 1) * 8;
#pragma unroll
            for (int g = 0; g < 8; ++g) { p[b8 + g] = __builtin_amdgcn_exp2f(p[b8 + g] - mn); ls += p[b8 + g]; }
            st.pp[k] = pack8(p, b8);
            asm volatile("" : "+v"(st.pp[k]), "+v"(ls));
        }
        if (k == 2 && (FAST || do_qk)) {
            f32x16 acc = f32x16{};
#pragma unroll
            for (int d0 = 0; d0 < 4; ++d0) acc = __builtin_amdgcn_mfma_f32_32x32x16_bf16(*(const LAS bf16x8*)(Kb + d0 * 2048), qr[d0], acc, 0, 0, 0);
            p0 = acc;
        }
        SBAR();
    }
    if (FAST || do_qk) {
        f32x16 acc = f32x16{};
#pragma unroll
        for (int d0 = 0; d0 < 4; ++d0) acc = __builtin_amdgcn_mfma_f32_32x32x16_bf16(*(const LAS bf16x8*)(Kb + d0 * 2048 + 512), qr[d0], acc, 0, 0, 0);
        p1 = acc;
    }
    if (FAST || do_sm) {
        st.lrun = st.lrun * al + ls;
        if (__any(al < 1.f)) {
            rescale_o(st.o, al);
        }
    }
}
__device__ __forceinline__ float max3f(float a, float b, float c) { float r; asm("v_max3_f32 %0, %1, %2, %3" : "=v"(r) : "v"(a), "v"(b), "v"(c)); return r; }
__device__ __forceinline__ void diff_iter_fast(DiffState& st, LAS unsigned char* L, const bf16x8 (&qr)[4], int kslot, int vslot, int kbase) {
    int vlane, koff;
    { const int l_ = lane_now(); vlane = ((l_ >> 4) & 1) * 32 + (l_ & 3) * 8 + (4 * (l_ >> 5) + ((l_ & 15) >> 2)) * 64; koff = kbase + (l_ >> 5) * 1024 + (l_ & 31) * 16; }
    f32x16& p0 = st.s0; f32x16& p1 = st.s1;
    const LAS unsigned char* Kb = L + kslot + koff;
    const LAS unsigned char* Vb = L + 49152 + vslot + vlane;
    s16x4 va[8]; bf16x8 kf[4];
#define VLOAD(dst, k) do { _Pragma("unroll") for (int d_ = 0; d_ < 4; ++d_) { dst[2 * d_] = vtr(Vb + (k) * 1024 + d_ * 4096); dst[2 * d_ + 1] = vtr(Vb + (k) * 1024 + d_ * 4096 + 512); } } while (0)
#define PVMMA(src, k) do { _Pragma("unroll") for (int d_ = 0; d_ < 4; ++d_) { const bf16x8 vf_ = (bf16x8){src[2 * d_][0], src[2 * d_][1], src[2 * d_][2], src[2 * d_][3], src[2 * d_ + 1][0], src[2 * d_ + 1][1], src[2 * d_ + 1][2], src[2 * d_ + 1][3]}; \
        st.o[d_] = __builtin_amdgcn_mfma_f32_32x32x16_bf16(vf_, st.pp[k], st.o[d_], 0, 0, 0); } } while (0)
#define EXPQ(p, b8, k) do { _Pragma("unroll") for (int g_ = 0; g_ < 8; ++g_) { p[(b8) + g_] = __builtin_amdgcn_exp2f(p[(b8) + g_] - mn); ls += p[(b8) + g_]; } st.pp[k] = pack8(p, b8); asm volatile("" : "+v"(st.pp[k]), "+v"(ls)); } while (0)
    SBAR();
    VLOAD(va, 0);
    float rm;
    { float a_ = max3f(p0[0], p0[1], p1[0]), b_ = max3f(p0[2], p0[3], p1[1]); a_ = max3f(a_, p1[2], p1[3]);
#pragma unroll
      for (int g = 4; g < 16; g += 4) { a_ = max3f(a_, p0[g], p0[g + 1]); b_ = max3f(b_, p0[g + 2], p0[g + 3]); a_ = max3f(a_, p1[g], p1[g + 1]); b_ = max3f(b_, p1[g + 2], p1[g + 3]); }
      rm = max3f(a_, b_, a_); }
    rm = max3f(rm, __shfl_xor(rm, 32), rm);
    const float mn = (rm > st.mrun + DIFF_THR) ? rm : st.mrun;
    const float al = __builtin_amdgcn_exp2f(st.mrun - mn); st.mrun = mn;
    float ls = 0.f;
    SBAR();
    PVMMA(va, 0); VLOAD(va, 1); EXPQ(p0, 0, 0);
    SBAR();
    PVMMA(va, 1); VLOAD(va, 2);
#pragma unroll
    for (int d0 = 0; d0 < 4; ++d0) kf[d0] = *(const LAS bf16x8*)(Kb + d0 * 2048);
    EXPQ(p0, 8, 1);
    SBAR();
    PVMMA(va, 2); VLOAD(va, 3); EXPQ(p1, 0, 2);
    { f32x16 acc = f32x16{};
#pragma unroll
      for (int d0 = 0; d0 < 4; ++d0) acc = __builtin_amdgcn_mfma_f32_32x32x16_bf16(kf[d0], qr[d0], acc, 0, 0, 0);
      p0 = acc; }
    SBAR();
#pragma unroll
    for (int d0 = 0; d0 < 4; ++d0) kf[d0] = *(const LAS bf16x8*)(Kb + d0 * 2048 + 512);
    PVMMA(va, 3); EXPQ(p1, 8, 3);
    SBAR();
    { f32x16 acc = f32x16{};
#pragma unroll
      for (int d0 = 0; d0 < 4; ++d0) acc = __builtin_amdgcn_mfma_f32_32x32x16_bf16(kf[d0], qr[d0], acc, 0, 0, 0);
      p1 = acc; }
    st.lrun = st.lrun * al + ls;
    if (__any(al < 1.f)) {
        rescale_o(st.o, al);
    }
#undef VLOAD
#undef PVMMA
#undef EXPQ
}
__device__ __forceinline__ void diff_unit(Frame& F, int b, int h, int qb, float lam) {
    const int w = F.wave, s = w >> 2, wq = w & 3;
    const int r0 = qb * 128 + wq * 32, cw = r0 >> 6;
    const int N = 2 * qb + 3, Nw = cw + 2;
    LAS unsigned char* L = F.lds + RING_OFF;
    bf16x8 qr[4];
    { const int l2 = lane_now(); const bf16* qp = F.QD + (size_t)(b * T + r0) * 512 + h * 128 + s * 64 + (unsigned)((l2 & 31) * 512 + (l2 >> 5) * 8);
#pragma unroll
      for (int d0 = 0; d0 < 4; ++d0) qr[d0] = *(const bf16x8*)(qp + 16 * d0); }
    const int pk = w < 4 ? (w & 1) * 4 : (w - 4) * 4, ks = (w >> 1) & 1;
    const unsigned ldsb_ = (unsigned)(uintptr_t)L;
#define DIFF_ISSUE_K(n_, so_) do { const int t_ = (n_) - 1; const bf16* src_ = t_ < 0 ? F.KDM + (h * 2 + ks) * 4096 : F.KD + (size_t)(((b * 4 + h) * 2 + ks) * 128 + t_) * 4096; \
        const unsigned lo_ = (unsigned)lane_now() * 16u; \
        _Pragma("unroll") for (int i_ = 0; i_ < 4 * PROBE_DMA_X; ++i_) glds16_asm((const char*)(src_ + (pk + (i_ & 3)) * 512) + lo_, (unsigned)__builtin_amdgcn_readfirstlane((int)(ldsb_ + (so_) + (4 * w + (i_ & 3)) * 1024))); } while (0)
#define DIFF_ISSUE_V(n_, so_) do { const int t_ = (n_) - 1; const bf16* src_ = t_ < 0 ? F.VDM + h * 8192 : F.VD + (size_t)((b * 4 + h) * 128 + t_) * 8192; \
        const unsigned lo_ = (unsigned)lane_now() * 16u; \
        _Pragma("unroll") for (int i_ = 0; i_ < 4 * PROBE_DMA_X; ++i_) glds16_asm((const char*)(src_ + (pk + (i_ & 3)) * 512) + lo_, (unsigned)__builtin_amdgcn_readfirstlane((int)(ldsb_ + 49152 + (so_) + (4 * (w - 4) + (i_ & 3)) * 1024))); } while (0)
    DiffState st;
#pragma unroll
    for (int d = 0; d < 4; ++d) st.o[d] = f32x16{};
    st.s0 = f32x16{}; st.s1 = f32x16{}; st.mrun = NEG; st.lrun = 0.f;
#pragma unroll
    for (int k = 0; k < 4; ++k) st.pp[k] = bf16x8{};
    const LAS float* lutb = (const LAS float*)(F.lds + RING_OFF + L_LUT) + h * 256;
    const float cfar = lutb[0];
    if (w < 4) { DIFF_ISSUE_K(0, 0); DIFF_ISSUE_K(1, 16384); DIFF_ISSUE_K(2, 32768); } else { DIFF_ISSUE_V(0, 0); }
    asm volatile("s_waitcnt vmcnt(0)" ::: "memory");
    __builtin_amdgcn_s_barrier();
    diff_iter<false>(st, L, qr, cfar, 0, 0, s * 8192, 0, true, false, false, false, false, lutb);
    int ks1 = 16384, ks3 = 0, vs_1 = 32768, vs1 = 16384;
    bool issued_prev = false;
#define DIFF_TOP(n_) do { if (issued_prev) asm volatile("s_waitcnt vmcnt(4) lgkmcnt(0)" ::: "memory"); else asm volatile("s_waitcnt vmcnt(0) lgkmcnt(0)" ::: "memory"); \
        __builtin_amdgcn_s_barrier();                                        \
        issued_prev = false; \
        if (w < 4) { if ((n_) + 3 < N) { DIFF_ISSUE_K((n_) + 3, ks3); issued_prev = true; } } else { if ((n_) + 1 < N) { DIFF_ISSUE_V((n_) + 1, vs1); issued_prev = true; } } } while (0)
#define DIFF_ADV() do { ks1 = ks1 == 32768 ? 0 : ks1 + 16384; ks3 = ks3 == 32768 ? 0 : ks3 + 16384; vs_1 = vs_1 == 32768 ? 0 : vs_1 + 16384; vs1 = vs1 == 32768 ? 0 : vs1 + 16384; } while (0)
#define DIFF_SLOW(n_) do { const int t = (n_) - 1; const int maxrel = (t < 0 ? -1 : 64 * t + 63) - r0; const int krel0 = (t < 0 ? -16 : 64 * t) - r0; \
        diff_iter<false>(st, L, qr, cfar, ks1, vs_1, s * 8192, 0, (n_) + 1 < Nw, (n_) < Nw, (n_) >= 1 && (n_) - 1 < Nw, maxrel > -91, t < 0, lutb + 191 + krel0); } while (0)
    int n = 0;
    DIFF_TOP(0); DIFF_SLOW(0); DIFF_ADV(); n = 1;
    for (; n <= Nw - 4; ++n) { DIFF_TOP(n); diff_iter_fast(st, L, qr, ks1, vs_1, s * 8192); DIFF_ADV(); }
    for (; n <= N; ++n) { DIFF_TOP(n); DIFF_SLOW(n); DIFF_ADV(); }
#undef DIFF_TOP
#undef DIFF_ADV
#undef DIFF_SLOW
    asm volatile("s_waitcnt vmcnt(0) lgkmcnt(0)" ::: "memory");
#undef DIFF_ISSUE_K
#undef DIFF_ISSUE_V
    const float inv = 1.f / (st.lrun + __shfl_xor(st.lrun, 32));
    LAS float* stg = (LAS float*)L;
    __syncthreads();
    const int ln_ = lane_now();
    if (s == 1) {
#pragma unroll
        for (int d = 0; d < 4; ++d)
#pragma unroll
            for (int g = 0; g < 16; ++g) stg[(d * 16 + g) * 256 + wq * 64 + ln_] = st.o[d][g] * inv;
    }
    __syncthreads();
    if (s == 0) {
        float ss = 0.f; float lam_ = lam; asm volatile("" : "+v"(lam_));
#pragma unroll
        for (int d = 0; d < 4; ++d)
#pragma unroll
            for (int g = 0; g < 16; ++g) { const float v = st.o[d][g] * inv - lam_ * stg[(d * 16 + g) * 256 + wq * 64 + ln_]; st.o[d][g] = v; ss += v * v; }
        ss += __shfl_xor(ss, 32);
        const float rn = (1.f - LAMBDA_INIT) / sqrtf(ss * (1.f / 128.f) + EPS);
        const LAS float* dn = (const LAS float*)(L + L_DN);
        const int l3 = lane_now(); bf16* op = F.MIX + (size_t)(b * T + r0) * D + h * 128 + (unsigned)((l3 & 31) * D + 4 * (l3 >> 5));
#pragma unroll
        for (int d = 0; d < 4; ++d)
#pragma unroll
            for (int g4 = 0; g4 < 4; ++g4) { const f32x4 gn = *(const LAS f32x4*)(dn + d * 32 + 8 * g4 + 4 * (l3 >> 5));
                v2u pk2_; pk2_.x = cvtpk(st.o[d][4 * g4] * rn * gn.x, st.o[d][4 * g4 + 1] * rn * gn.y); pk2_.y = cvtpk(st.o[d][4 * g4 + 2] * rn * gn.z, st.o[d][4 * g4 + 3] * rn * gn.w);
                *(v2u*)(op + d * 32 + 8 * g4) = pk2_; }
    }
    __syncthreads();
}
__device__ __forceinline__ void sb_scan_block(const f32x16& z, int kb, int t, int i, int hh, float& C, f32x16& a) {
    float x[16], lsv[16]; bool val[16];
#pragma unroll
    for (int g = 0; g < 16; ++g) {
        const int key = kb + crow(g, hh);
        val[g] = t < 0 ? key < 16 : (64 * t + key) < i;
        const float zz = z[g], e = __builtin_amdgcn_exp2f(-fabsf(zz) * LOG2E), lg = __builtin_amdgcn_logf(1.f + e) * 0.6931471805599453f;
        lsv[g] = fminf(zz, 0.f) - lg; x[g] = val[g] ? lsv[g] - zz : 0.f;
    }
    float sg[4], sp[4];
#pragma unroll
    for (int q = 0; q < 4; ++q) { sg[q] = (x[4 * q] + x[4 * q + 1]) + (x[4 * q + 2] + x[4 * q + 3]); sp[q] = __shfl_xor(sg[q], 32); }
    float above = 0.f;
#pragma unroll
    for (int q = 3; q >= 0; --q) {
        const float Tq = above + (hh == 0 ? sp[q] : 0.f);
        const float e2 = x[4 * q + 3], e1 = e2 + x[4 * q + 2], e0 = e1 + x[4 * q + 1], base = C + Tq;
        a[4 * q + 3] = val[4 * q + 3] ? __builtin_amdgcn_exp2f((lsv[4 * q + 3] + base) * LOG2E) : 0.f;
        a[4 * q + 2] = val[4 * q + 2] ? __builtin_amdgcn_exp2f((lsv[4 * q + 2] + base + e2) * LOG2E) : 0.f;
        a[4 * q + 1] = val[4 * q + 1] ? __builtin_amdgcn_exp2f((lsv[4 * q + 1] + base + e1) * LOG2E) : 0.f;
        a[4 * q + 0] = val[4 * q + 0] ? __builtin_amdgcn_exp2f((lsv[4 * q + 0] + base + e0) * LOG2E) : 0.f;
        above += sg[q] + sp[q];
    }
    C += above;
}
__device__ __forceinline__ void sb_unit(Frame& F, int b, int h, int rb) {
    const int lane = lane_now(), r = lane & 31, hh = lane >> 5, r0 = rb * 32, i = r0 + r;
    LAS unsigned char* Vst = F.lds + RING_OFF + F.wave * 8192;
    bf16x8 qr[4];
    { const int l2 = lane_now(); const bf16* qp = F.QS + (size_t)(b * T + r0) * 512 + h * 64 + (unsigned)((l2 & 31) * 512 + (l2 >> 5) * 8);
#pragma unroll
      for (int d0 = 0; d0 < 4; ++d0) qr[d0] = *(const bf16x8*)(qp + 16 * d0); }
    f32x16 o[2]; o[0] = f32x16{}; o[1] = f32x16{};
    float C = 0.f;
    const int vlane = ((lane >> 4) & 1) * 32 + (lane & 3) * 8 + (4 * hh + ((lane & 15) >> 2)) * 64;
    for (int t = r0 >> 6; t >= -1; --t) {
        const bf16* kt = t < 0 ? F.KSM + h * 4096 : F.KS + (size_t)((b * 8 + h) * 128 + t) * 4096;
        const bf16* vt = t < 0 ? F.VSM + h * 4096 : F.VS + (size_t)((b * 8 + h) * 128 + t) * 4096;
        asm volatile("s_waitcnt lgkmcnt(0)" ::: "memory");
#pragma unroll
        for (int p = 0; p < 8; ++p) glds16((const char*)(vt + p * 512) + (unsigned)lane_now() * 16u, Vst + p * 1024);
        f32x16 z0 = f32x16{}, z1 = f32x16{};
#pragma unroll
        for (int d0 = 0; d0 < 4; ++d0) {
            const unsigned ko_ = (unsigned)(opaque(hh) * 1024 + r * 16);
            const bf16x8 a0 = *(const bf16x8*)((const char*)(kt + 2 * d0 * 512) + ko_), a1 = *(const bf16x8*)((const char*)(kt + 2 * d0 * 512 + 256) + ko_);
            z0 = __builtin_amdgcn_mfma_f32_32x32x16_bf16(a0, qr[d0], z0, 0, 0, 0);
            z1 = __builtin_amdgcn_mfma_f32_32x32x16_bf16(a1, qr[d0], z1, 0, 0, 0);
        }
        f32x16 a0v, a1v;
        sb_scan_block(z1, 32, t, i, hh, C, a1v);
        sb_scan_block(z0, 0, t, i, hh, C, a0v);
        bf16x8 pa[4]; pa[0] = pack8(a0v, 0); pa[1] = pack8(a0v, 8); pa[2] = pack8(a1v, 0); pa[3] = pack8(a1v, 8);
        asm volatile("s_waitcnt vmcnt(0)" ::: "memory");
#pragma unroll
        for (int d = 0; d < 2; ++d)
#pragma unroll
            for (int k = 0; k < 4; ++k) {
                const s16x4 lo = vtr(Vst + vlane + d * 4096 + k * 1024), hi = vtr(Vst + vlane + d * 4096 + k * 1024 + 512);
                const bf16x8 vf = (bf16x8){lo[0], lo[1], lo[2], lo[3], hi[0], hi[1], hi[2], hi[3]};
                o[d] = __builtin_amdgcn_mfma_f32_32x32x16_bf16(vf, pa[k], o[d], 0, 0, 0);
            }
        if (__all(C <= -104.f)) break;
    }
    float ss = 0.f;
#pragma unroll
    for (int d = 0; d < 2; ++d)
#pragma unroll
        for (int g = 0; g < 16; ++g) ss += o[d][g] * o[d][g];
    ss += __shfl_xor(ss, 32);
    const float rn = 1.f / sqrtf(ss * (1.f / 64.f) + EPS);
    const LAS float* sn = (const LAS float*)(F.lds + RING_OFF + L_SN);
    const int l3 = lane_now(); bf16* op = F.MIX + (size_t)(b * T + r0) * D + 512 + h * 64 + (unsigned)((l3 & 31) * D + 4 * (l3 >> 5));
#pragma unroll
    for (int d = 0; d < 2; ++d)
#pragma unroll
        for (int g4 = 0; g4 < 4; ++g4) { const f32x4 gn = *(const LAS f32x4*)(sn + d * 32 + 8 * g4 + 4 * hh);
            v2u pk; pk.x = cvtpk(o[d][4 * g4] * rn * gn.x, o[d][4 * g4 + 1] * rn * gn.y); pk.y = cvtpk(o[d][4 * g4 + 2] * rn * gn.z, o[d][4 * g4 + 3] * rn * gn.w);
            *(v2u*)(op + d * 32 + 8 * g4) = pk; }
    asm volatile("s_waitcnt lgkmcnt(0)" ::: "memory");
}
__device__ __forceinline__ void p2_attention(Frame& F) {
    p2_tables(F);
    float s1 = 0.f, s2 = 0.f;
    for (int d = 0; d < 64; ++d) { s1 += F.lq1[d] * F.lk1[d]; s2 += F.lq2[d] * F.lk2[d]; }
    const float lam = __builtin_bit_cast(float, __builtin_amdgcn_readfirstlane(__builtin_bit_cast(int, __expf(s1) - __expf(s2) + LAMBDA_INIT)));
    __syncthreads();
#ifdef PROBE_SB2
    for (int u = F.vcu * NWAVES + F.wave; u < NB * 8 * 256; u += F.G * NWAVES) sb_unit(F, u >> 11, (u >> 8) & 7, u & 255);
#endif
    for (int u = F.vcu * NWAVES + F.wave; u < NB * 8 * 256; u += F.G * NWAVES) sb_unit(F, u >> 11, (u >> 8) & 7, u & 255);
    __syncthreads();
    for (int v = F.vcu; v < 256; v += F.G) { const int bh = v >> 5, p = v & 31; diff_unit(F, bh >> 2, bh & 3, p, lam); diff_unit(F, bh >> 2, bh & 3, 63 - p, lam); }
}
}

struct NaiveArgs { const bf16 *QD, *KD, *VD, *KDM, *VDM, *QS, *KS, *VS, *KSM, *VSM; bf16* MIX; const float *rel_table, *diff_norm, *sb_norm, *lq1, *lk1, *lq2, *lk2; };
__global__ void __launch_bounds__(64) naive_diff(NaiveArgs a) {
    const int blk = blockIdx.x, bh = blk >> 7, b = bh >> 2, h = bh & 3, c = blk & 127, lane = threadIdx.x, i = c * 64 + lane, row = b * T + i;
    float s1 = 0.f, s2 = 0.f;
    for (int d = 0; d < 64; ++d) { s1 += a.lq1[d] * a.lk1[d]; s2 += a.lq2[d] * a.lk2[d]; }
    const float lam = __expf(s1) - __expf(s2) + LAMBDA_INIT;
    float res[128];
#pragma unroll
    for (int d = 0; d < 128; ++d) res[d] = 0.f;
    for (int s = 0; s < 2; ++s) {
        float q[64];
        const bf16* qp = a.QD + (size_t)row * 512 + h * 128 + s * 64;
#pragma unroll
        for (int d = 0; d < 64; ++d) q[d] = bf2f(qp[d]);
        float o[128];
#pragma unroll
        for (int d = 0; d < 128; ++d) o[d] = 0.f;
        float mx = -1.0e30f, l = 0.f;
        for (int t = -1; t <= c; ++t) {
            const bf16* kt = t < 0 ? a.KDM + (h * 2 + s) * 4096 : a.KD + (size_t)(((b * 4 + h) * 2 + s) * 128 + t) * 4096;
            const bf16* vt = t < 0 ? a.VDM + h * 8192 : a.VD + (size_t)((b * 4 + h) * 128 + t) * 8192;
            const int nb = t < 0 ? 1 : 4;
            for (int kb = 0; kb < nb; ++kb) {
                float sc[16]; float bm = -1.0e30f;
#pragma unroll
                for (int kk = 0; kk < 16; ++kk) { const int key = kb * 16 + kk; float acc = 0.f;
#pragma unroll
                    for (int ch = 0; ch < 8; ++ch) { const v4u kv = *(const v4u*)(kt + ch * 512 + key * 8);
                        acc += q[ch * 8 + 0] * bf2f((unsigned short)(kv.x & 0xffff)) + q[ch * 8 + 1] * bf2f((unsigned short)(kv.x >> 16)) + q[ch * 8 + 2] * bf2f((unsigned short)(kv.y & 0xffff)) + q[ch * 8 + 3] * bf2f((unsigned short)(kv.y >> 16))
                             + q[ch * 8 + 4] * bf2f((unsigned short)(kv.z & 0xffff)) + q[ch * 8 + 5] * bf2f((unsigned short)(kv.z >> 16)) + q[ch * 8 + 6] * bf2f((unsigned short)(kv.w & 0xffff)) + q[ch * 8 + 7] * bf2f((unsigned short)(kv.w >> 16)); }
                    const int rel = t < 0 ? (key - 16 - i) : (t * 64 + key - i);
                    acc += a.rel_table[t5_bucket(rel) * 4 + h] * LOG2E;
                    sc[kk] = acc; bm = fmaxf(bm, acc); }
                const float mn = fmaxf(mx, bm), al = __builtin_amdgcn_exp2f(mx - mn); mx = mn; l *= al;
#pragma unroll
                for (int d = 0; d < 128; ++d) o[d] *= al;
#pragma unroll
                for (int kk = 0; kk < 16; ++kk) { const int key = kb * 16 + kk; const float p = __builtin_amdgcn_exp2f(sc[kk] - mn); l += p;
#pragma unroll
                    for (int db = 0; db < 4; ++db)
#pragma unroll
                        for (int q4 = 0; q4 < 4; ++q4) { const v4u vv = *(const v4u*)(vt + db * 2048 + key * 32 + q4 * 8); const int d0 = db * 32 + q4 * 8;
                            o[d0 + 0] += p * bf2f((unsigned short)(vv.x & 0xffff)); o[d0 + 1] += p * bf2f((unsigned short)(vv.x >> 16)); o[d0 + 2] += p * bf2f((unsigned short)(vv.y & 0xffff)); o[d0 + 3] += p * bf2f((unsigned short)(vv.y >> 16));
                            o[d0 + 4] += p * bf2f((unsigned short)(vv.z & 0xffff)); o[d0 + 5] += p * bf2f((unsigned short)(vv.z >> 16)); o[d0 + 6] += p * bf2f((unsigned short)(vv.w & 0xffff)); o[d0 + 7] += p * bf2f((unsigned short)(vv.w >> 16)); } }
            }
        }
        const float f = (s == 0 ? 1.f : -lam) / l;
#pragma unroll
        for (int d = 0; d < 128; ++d) res[d] += f * o[d];
    }
    float ss = 0.f;
#pragma unroll
    for (int d = 0; d < 128; ++d) ss += res[d] * res[d];
    const float r = (1.f - LAMBDA_INIT) / sqrtf(ss * (1.f / 128.f) + EPS);
    bf16* op = a.MIX + (size_t)row * D + h * 128;
#pragma unroll
    for (int d = 0; d < 128; ++d) op[d] = (bf16)f2bf(res[d] * r * a.diff_norm[d]);
}
__global__ void __launch_bounds__(64) naive_sb(NaiveArgs a) {
    const int blk = blockIdx.x, bh = blk >> 7, b = bh >> 3, h = bh & 7, c = blk & 127, lane = threadIdx.x, i = c * 64 + lane, row = b * T + i;
    float q[64], o[64];
    const bf16* qp = a.QS + (size_t)row * 512 + h * 64;
#pragma unroll
    for (int d = 0; d < 64; ++d) { q[d] = bf2f(qp[d]); o[d] = 0.f; }
    float cum = 0.f;
    for (int t = c; t >= -1; --t) {
        const bf16* kt = t < 0 ? a.KSM + h * 4096 : a.KS + (size_t)((b * 8 + h) * 128 + t) * 4096;
        const bf16* vt = t < 0 ? a.VSM + h * 4096 : a.VS + (size_t)((b * 8 + h) * 128 + t) * 4096;
        for (int key = (t < 0 ? 15 : 63); key >= 0; --key) {
            float z = 0.f;
#pragma unroll
            for (int ch = 0; ch < 8; ++ch) { const v4u kv = *(const v4u*)(kt + ch * 512 + key * 8);
                z += q[ch * 8 + 0] * bf2f((unsigned short)(kv.x & 0xffff)) + q[ch * 8 + 1] * bf2f((unsigned short)(kv.x >> 16)) + q[ch * 8 + 2] * bf2f((unsigned short)(kv.y & 0xffff)) + q[ch * 8 + 3] * bf2f((unsigned short)(kv.y >> 16))
                   + q[ch * 8 + 4] * bf2f((unsigned short)(kv.z & 0xffff)) + q[ch * 8 + 5] * bf2f((unsigned short)(kv.z >> 16)) + q[ch * 8 + 6] * bf2f((unsigned short)(kv.w & 0xffff)) + q[ch * 8 + 7] * bf2f((unsigned short)(kv.w >> 16)); }
            const bool valid = t < 0 || (t * 64 + key) < i;
            const float ls = fminf(z, 0.f) - __logf(1.f + __expf(-fabsf(z)));
            const float lk = ls - z;
            const float w = valid ? __expf(ls + cum) : 0.f;
            cum += valid ? lk : 0.f;
#pragma unroll
            for (int db = 0; db < 2; ++db)
#pragma unroll
                for (int q4 = 0; q4 < 4; ++q4) { const v4u vv = *(const v4u*)(vt + db * 2048 + key * 32 + q4 * 8); const int d0 = db * 32 + q4 * 8;
                    o[d0 + 0] += w * bf2f((unsigned short)(vv.x & 0xffff)); o[d0 + 1] += w * bf2f((unsigned short)(vv.x >> 16)); o[d0 + 2] += w * bf2f((unsigned short)(vv.y & 0xffff)); o[d0 + 3] += w * bf2f((unsigned short)(vv.y >> 16));
                    o[d0 + 4] += w * bf2f((unsigned short)(vv.z & 0xffff)); o[d0 + 5] += w * bf2f((unsigned short)(vv.z >> 16)); o[d0 + 6] += w * bf2f((unsigned short)(vv.w & 0xffff)); o[d0 + 7] += w * bf2f((unsigned short)(vv.w >> 16)); }
        }
    }
    float ss = 0.f;
#pragma unroll
    for (int d = 0; d < 64; ++d) ss += o[d] * o[d];
    const float r = 1.f / sqrtf(ss * (1.f / 64.f) + EPS);
    bf16* op = a.MIX + (size_t)row * D + 512 + h * 64;
#pragma unroll
    for (int d = 0; d < 64; ++d) op[d] = (bf16)f2bf(o[d] * r * a.sb_norm[d]);
}

#ifndef MK_REPEAT
#define MK_REPEAT 0
#endif
#define REP(k) for (int rep_ = 0; rep_ < (((MK_REPEAT) >> (k)) & 1) + 1; ++rep_)
struct Args { const float* in[19]; float* out; unsigned char* ws; int ph_lo, ph_hi; };
constexpr int NPHASE = 8;
__global__ void __launch_bounds__(NWAVES * 64, 2) fwd(Args args) {
    extern __shared__ __attribute__((aligned(16))) unsigned char lds[];
    Frame F;
    F.lds = (LAS unsigned char*)lds;
    F.MISC = (volatile LAS unsigned*)(F.lds + MISC_OFF);
    F.wave = __builtin_amdgcn_readfirstlane((int)threadIdx.x >> 6);
    F.G = gridDim.x; { const int bx = blockIdx.x; F.vcu = (F.G % 8 == 0) ? (bx % 8) * (F.G / 8) + bx / 8 : bx; }
    unsigned char* ws = args.ws;
    F.ctl = (gu32*)(ws + WS_CTL);
    F.x = args.in[0]; F.meta = args.in[1]; F.rel_table = args.in[2]; F.attn_norm = args.in[3]; F.w_in = args.in[4]; F.lq1 = args.in[5]; F.lk1 = args.in[6]; F.lq2 = args.in[7]; F.lk2 = args.in[8];
    F.diff_norm = args.in[9]; F.sb_norm = args.in[10]; F.w_out = args.in[11]; F.ffn_norm = args.in[12]; F.w_group = args.in[13]; F.w_router = args.in[14]; F.w_gate = args.in[15]; F.w_up = args.in[16];
    F.w_down = args.in[17]; F.final_norm = args.in[18]; F.out = args.out;
    F.Win_t = (bf16*)(ws + WS_WIN); F.Wout_t = (bf16*)(ws + WS_WOUT); F.Wgu_t = (bf16*)(ws + WS_WGU); F.Wd_t = (bf16*)(ws + WS_WD);
    F.HN = (bf16*)(ws + WS_HN); F.MIX = (bf16*)(ws + WS_HN); F.QD = (bf16*)(ws + WS_QD); F.KD = (bf16*)(ws + WS_KD); F.VD = (bf16*)(ws + WS_VD); F.QS = (bf16*)(ws + WS_QS); F.KS = (bf16*)(ws + WS_KS); F.VS = (bf16*)(ws + WS_VS);
    F.HN2 = (bf16*)(ws + WS_HN2); F.HID = (bf16*)(ws + WS_HID); F.Y = (bf16*)(ws + WS_Y);
    F.KDM = (bf16*)(ws + WS_META); F.VDM = F.KDM + 8 * 4096; F.KSM = F.VDM + 4 * 8192; F.VSM = F.KSM + 8 * 4096;
    F.list = (int*)(ws + WS_LIST); F.toke = (int*)(ws + WS_TOKE); F.tokw = (float*)(ws + WS_TOKW);
    for (int u = threadIdx.x; u < (LDS_BYTES - LDSCTL_OFF) / 4; u += NWAVES * 64) ((LAS unsigned*)(F.lds + LDSCTL_OFF))[u] = 0u;
    __syncthreads();
    XcdBarrier bar = xcd_barrier_post((unsigned*)(F.ctl + CW_BAR), F.MISC + 8, (int)threadIdx.x);
    const int lo = args.ph_lo, hi = args.ph_hi;
#ifndef PH_MASK
#define PH_MASK 0xFF
#endif
#define IN(k) ((((PH_MASK) >> (k)) & 1) && lo <= (k) && (k) < hi)
#define BOTH(k) (IN(k) && IN((k) + 1))
#define GRID_BAR() xcd_barrier(bar, F.wave * 64 + lane_now())
    if (IN(0)) { REP(0) p0_prologue(F); if (BOTH(0)) GRID_BAR(); }
    if (IN(1)) {
        pg8::Gemm g{F.HN, F.Win_t, M, NPROJ, D}; pg8::StaticOrder S; S.init(M, NPROJ, F.G, (int)blockIdx.x);
        pg8::EpiProj E{F.QD, F.KD, F.VD, F.QS, F.KS, F.VS, C2};
        REP(1) pg8::gemm_phase<pg8::EpiProj, pg8::StaticOrder, true, true, false>(F.lds + RING_OFF, g, S, E, F.wave);
        if (BOTH(1)) GRID_BAR();
    }
    if (IN(2)) { REP(2) att::p2_attention(F); if (BOTH(2)) GRID_BAR(); }
    if (IN(3)) {
        pg8::Gemm g{F.MIX, F.Wout_t, M, D, D}; pg8::StaticOrder S; S.init(M, D, F.G, (int)blockIdx.x);
        pg8::EpiRes E{F.x, F.out, D};
        REP(3) pg8::gemm_phase<pg8::EpiRes, pg8::StaticOrder, true, true, false>(F.lds + RING_OFF, g, S, E, F.wave);
        if (BOTH(3)) GRID_BAR();
    }
    if (IN(4)) { p4_route(F); if (BOTH(4)) GRID_BAR(); }
    if (IN(5)) {
        pg8::Gemm g{F.HN2, F.Wgu_t, M, 1024, D}; pg8::GroupedOrder S; S.init((const unsigned*)(F.ctl + CW_CNT), F.list, F.G, (int)blockIdx.x);
        pg8::EpiSwiGLU E{F.HID};
        REP(5) pg8::gemm_phase<pg8::EpiSwiGLU, pg8::GroupedOrder, true, true, true>(F.lds + RING_OFF, g, S, E, F.wave);
        if (BOTH(5)) GRID_BAR();
    }
    if (IN(6)) {
        pg8::Gemm g{F.HID, F.Wd_t, SLOT_ROWS, 1024, DEXP}; pg8::GroupedOrder S; S.init((const unsigned*)(F.ctl + CW_CNT), F.list, F.G, (int)blockIdx.x);
        pg8::EpiY E{F.Y};
        REP(6) pg8::gemm_phase<pg8::EpiY, pg8::GroupedOrder, true, true, false>(F.lds + RING_OFF, g, S, E, F.wave);
        if (BOTH(6)) GRID_BAR();
    }
    if (IN(7)) p7_final(F);
#undef IN
#undef BOTH
#undef GRID_BAR
}

#ifndef MK_STAGED
#define MK_STAGED 0
#endif
#ifndef MK_NAIVE
#define MK_NAIVE 0
#endif
extern "C" void kernel_launch(void* const* d_in, const int* in_sizes, int n_in, void* d_out, int out_size, void* d_ws, size_t ws_size, hipStream_t stream) {
    static int grid = 0;
    if (grid == 0) {
        if (n_in != 19 || out_size != M * D || ws_size < WS_END) { fprintf(stderr, "kernel_launch: unexpected shapes (n_in %d, out %d, ws %zu); nothing launched\n", n_in, out_size, ws_size); grid = -1; return; }
        int dev = 0, cus = 0, per_cu = 0;
        if (hipGetDevice(&dev) != hipSuccess || hipDeviceGetAttribute(&cus, hipDeviceAttributeMultiprocessorCount, dev) != hipSuccess) { grid = -1; return; }
        if (hipFuncSetAttribute((const void*)fwd, hipFuncAttributeMaxDynamicSharedMemorySize, LDS_BYTES) != hipSuccess) { fprintf(stderr, "kernel_launch: hipFuncSetAttribute failed\n"); grid = -1; return; }
        if (hipOccupancyMaxActiveBlocksPerMultiprocessor(&per_cu, (const void*)fwd, NWAVES * 64, LDS_BYTES) != hipSuccess || per_cu < 1) fprintf(stderr, "kernel_launch: occupancy query says %d per CU\n", per_cu);
        (void)hipGetLastError();
        grid = cus;
    }
    if (grid < 0) return;
    (void)hipMemsetAsync((char*)d_ws + WS_CTL, 0, CTL_ZERO_BYTES, stream);
    Args a{};
    for (int i = 0; i < 19; ++i) a.in[i] = (const float*)d_in[i];
    a.out = (float*)d_out; a.ws = (unsigned char*)d_ws;
#if MK_STAGED
    unsigned char* ws = (unsigned char*)d_ws;
    NaiveArgs na{};
    na.QD = (const bf16*)(ws + WS_QD); na.KD = (const bf16*)(ws + WS_KD); na.VD = (const bf16*)(ws + WS_VD); na.QS = (const bf16*)(ws + WS_QS); na.KS = (const bf16*)(ws + WS_KS); na.VS = (const bf16*)(ws + WS_VS);
    na.KDM = (const bf16*)(ws + WS_META); na.VDM = na.KDM + 8 * 4096; na.KSM = na.VDM + 4 * 8192; na.VSM = na.KSM + 8 * 4096; na.MIX = (bf16*)(ws + WS_HN);
    na.rel_table = (const float*)d_in[2]; na.diff_norm = (const float*)d_in[9]; na.sb_norm = (const float*)d_in[10]; na.lq1 = (const float*)d_in[5]; na.lk1 = (const float*)d_in[6]; na.lq2 = (const float*)d_in[7]; na.lk2 = (const float*)d_in[8];
    for (int ph = 0; ph < NPHASE; ++ph) {
        if (MK_NAIVE && ph == 2) { hipLaunchKernelGGL(naive_diff, dim3(NB * 4 * 128), dim3(64), 0, stream, na); hipLaunchKernelGGL(naive_sb, dim3(NB * 8 * 128), dim3(64), 0, stream, na); continue; }
        a.ph_lo = ph; a.ph_hi = ph + 1;
        hipLaunchKernelGGL(fwd, dim3(grid), dim3(NWAVES * 64), LDS_BYTES, stream, a);
    }
#else
    a.ph_lo = 0; a.ph_hi = NPHASE;
    hipLaunchKernelGGL(fwd, dim3(grid), dim3(NWAVES * 64), LDS_BYTES, stream, a);
#endif
    const hipError_t le = hipPeekAtLastError();
    if (le != hipSuccess) fprintf(stderr, "kernel_launch: launch failed: %s\n", hipGetErrorName(le));
}
```

```cpp
#include <hip/hip_runtime.h>
#include <cstdio>
#include <cstdint>
namespace pg8 {
#define PG8_LAS __attribute__((address_space(3)))
typedef unsigned short bf16_t;
typedef short bf16x8 __attribute__((ext_vector_type(8)));
typedef float f32x4 __attribute__((ext_vector_type(4)));
typedef unsigned u32x4 __attribute__((ext_vector_type(4)));
constexpr int BM = 256, BK = 64, HALF = 128, HTB = HALF * BK * 2  , STAGE_BYTES = 8 * HTB, NXCD = 8, WGM = 8;

__host__ __device__ __forceinline__ int lds_byte(int r, int c) { const int st = (r >> 4) * 2 + (c >> 5), rr = r & 15, cc = c & 31, ob = rr * 64 + cc * 2; return st * 1024 + (ob ^ (((ob >> 9) & 1) << 5)); }
__host__ __device__ __forceinline__ void stage_rc(int b, int& R, int& C) { const int st = b / 1024, sb = b % 1024, swz = sb ^ (((sb >> 9) & 1) << 5); R = (st >> 1) * 16 + swz / 64; C = (st & 1) * 32 + (swz % 64) / 2; }
__host__ __device__ __forceinline__ int perm32(int rho) { const int n = rho >> 4, i = rho & 15; return 8 * (i >> 2) + 4 * n + (i & 3); }

struct Unit { int pm, pn, e, lt; };
struct Gemm { const bf16_t* A; const bf16_t* Bt; int M, N, K; };

struct StaticOrder {
    int nM, nN, nwg, G, c;
    __host__ __device__ void init(int M, int N, int G_, int c_) { nM = M / BM; nN = N / BM; nwg = nM * nN; G = G_; c = c_; }
    __host__ __device__ bool next(int i, Unit& u) const {
        const long L = (long)i * G + c; if (L >= nwg) return false;
        int wgid = (int)L; { const int q = nwg / NXCD, r = nwg % NXCD, xcd = wgid % NXCD, off = wgid / NXCD; wgid = (xcd < r ? xcd * (q + 1) : r * (q + 1) + (xcd - r) * q) + off; }
        const int nig = WGM * nN, gid = wgid / nig, fm = gid * WGM, gsz = (nM - fm) < WGM ? (nM - fm) : WGM;
        u.pm = fm + ((wgid % nig) % gsz); u.pn = (wgid % nig) / gsz; u.e = 0; u.lt = 0; return true;
    }
    __device__ __forceinline__ void a_ready(const Unit&) const {}
    __device__ __forceinline__ void done(const Unit&) const {}
};

__device__ __forceinline__ unsigned cvt_pk_bf16(float lo, float hi) { unsigned r; asm volatile("v_cvt_pk_bf16_f32 %0, %1, %2" : "=v"(r) : "v"(lo), "v"(hi)); return r; }
typedef float f32x2 __attribute__((ext_vector_type(2)));

struct EpiProj {
    static constexpr bool PERM = true, AFTER_DRAIN = false;
    bf16_t *Qd, *Kd, *Vd, *Qs, *Ks, *Vs; float c2;
    __device__ __forceinline__ void operator()(const f32x4 (&acc)[2][2][4][2], const Unit& u, int wr, int wc, int fr, int fq) const {
        const int sec = u.pn >> 1;
        const float sc = sec == 0 ? c2 : (sec == 3 ? 0.125f : 1.f);
        const int row0 = u.pm * BM + wr * 64 + fr;
#pragma unroll
        for (int ai = 0; ai < 2; ++ai)
#pragma unroll
            for (int m = 0; m < 4; ++m) {
                const int row = row0 + ai * HALF + m * 16, b = row >> 13, fi = row & 8191, tile = fi >> 6, key = fi & 63;
#pragma unroll
                for (int bj = 0; bj < 2; ++bj) {
                    const int cc = (u.pn & 1) * 256 + bj * HALF + wc * 32 + 8 * fq;
                    const f32x4 v0 = acc[ai][bj][m][0] * sc, v1 = acc[ai][bj][m][1] * sc;
                    u32x4 w; w.x = cvt_pk_bf16(v0[0], v0[1]); w.y = cvt_pk_bf16(v0[2], v0[3]); w.z = cvt_pk_bf16(v1[0], v1[1]); w.w = cvt_pk_bf16(v1[2], v1[3]);
                    bf16_t* p;
                    if (sec == 0) p = Qd + (size_t)row * 512 + cc;
                    else if (sec == 3) p = Qs + (size_t)row * 512 + cc;
                    else if (sec == 1) { const int h = cc >> 7, s = (cc >> 6) & 1, ch = (cc & 63) >> 3; p = Kd + (size_t)(((b * 4 + h) * 2 + s) * 128 + tile) * 4096 + ch * 512 + key * 8; }
                    else if (sec == 2) { const int h = cc >> 7, d = cc & 127; p = Vd + (size_t)((b * 4 + h) * 128 + tile) * 8192 + (d >> 5) * 2048 + key * 32 + (d & 31); }
                    else if (sec == 4) { const int h = cc >> 6, ch = (cc & 63) >> 3; p = Ks + (size_t)((b * 8 + h) * 128 + tile) * 4096 + ch * 512 + key * 8; }
                    else { const int h = cc >> 6, d = cc & 63; p = Vs + (size_t)((b * 8 + h) * 128 + tile) * 4096 + (d >> 5) * 2048 + key * 32 + (d & 31); }
                    *(u32x4*)p = w;
                }
            }
    }
};
struct EpiRes {
    static constexpr bool PERM = false, AFTER_DRAIN = false;
    const float* base; float* out; int ldc;
    __device__ __forceinline__ void operator()(const f32x4 (&acc)[2][2][4][2], const Unit& u, int wr, int wc, int fr, int fq) const {
        const int row0 = u.pm * BM + wr * 64 + fr, col0 = u.pn * BM + wc * 32 + 4 * fq;
#pragma unroll
        for (int ai = 0; ai < 2; ++ai)
#pragma unroll
            for (int m = 0; m < 4; ++m) { const size_t off = (size_t)(row0 + ai * HALF + m * 16) * ldc + col0;
#pragma unroll
                for (int bj = 0; bj < 2; ++bj)
#pragma unroll
                    for (int n = 0; n < 2; ++n) { const f32x4 bs = *(const f32x4*)(base + off + bj * HALF + n * 16); *(f32x4*)(out + off + bj * HALF + n * 16) = bs + acc[ai][bj][m][n]; } }
    }
};
__device__ __forceinline__ float silu_mul(float g, float u) { return g * __builtin_amdgcn_rcpf(1.0f + __builtin_amdgcn_exp2f(-1.4426950408889634f * g)) * u; }
struct EpiSwiGLU {
    static constexpr bool PERM = true, AFTER_DRAIN = false;
    bf16_t* H;
    __device__ __forceinline__ void operator()(const f32x4 (&acc)[2][2][4][2], const Unit& u, int wr, int wc, int fr, int fq) const {
        const int row0 = u.pm * BM + wr * 64 + fr, col0 = (u.pn & 3) * 128 + wc * 32 + 8 * fq;
#pragma unroll
        for (int ai = 0; ai < 2; ++ai)
#pragma unroll
            for (int m = 0; m < 4; ++m) {
                const f32x4 g0 = acc[ai][0][m][0], g1 = acc[ai][0][m][1], u0 = acc[ai][1][m][0], u1 = acc[ai][1][m][1];
                u32x4 w; w.x = cvt_pk_bf16(silu_mul(g0[0], u0[0]), silu_mul(g0[1], u0[1])); w.y = cvt_pk_bf16(silu_mul(g0[2], u0[2]), silu_mul(g0[3], u0[3]));
                w.z = cvt_pk_bf16(silu_mul(g1[0], u1[0]), silu_mul(g1[1], u1[1])); w.w = cvt_pk_bf16(silu_mul(g1[2], u1[2]), silu_mul(g1[3], u1[3]));
                *(u32x4*)(H + (size_t)(row0 + ai * HALF + m * 16) * 512 + col0) = w;
            }
    }
};
struct EpiY {
    static constexpr bool PERM = true, AFTER_DRAIN = false;
    bf16_t* Y;
    __device__ __forceinline__ void operator()(const f32x4 (&acc)[2][2][4][2], const Unit& u, int wr, int wc, int fr, int fq) const {
        const int row0 = u.pm * BM + wr * 64 + fr, col0 = (u.pn & 3) * BM + wc * 32 + 8 * fq;
#pragma unroll
        for (int ai = 0; ai < 2; ++ai)
#pragma unroll
            for (int m = 0; m < 4; ++m) { bf16_t* rowp = Y + (size_t)(row0 + ai * HALF + m * 16) * 1024 + col0;
#pragma unroll
                for (int bj = 0; bj < 2; ++bj) { const f32x4 v0 = acc[ai][bj][m][0], v1 = acc[ai][bj][m][1];
                    u32x4 w; w.x = cvt_pk_bf16(v0[0], v0[1]); w.y = cvt_pk_bf16(v0[2], v0[3]); w.z = cvt_pk_bf16(v1[0], v1[1]); w.w = cvt_pk_bf16(v1[2], v1[3]);
                    *(u32x4*)(rowp + bj * HALF) = w; } }
    }
};
struct GroupedOrder {
    int pre[17], cnt[16]; const int* list; int G, c;
    __device__ __forceinline__ void init(const unsigned* gcnt, const int* list_, int G_, int c_) {
        list = list_; G = G_; c = c_; int a = 0;
#pragma unroll
        for (int e = 0; e < 16; ++e) { cnt[e] = __builtin_amdgcn_readfirstlane((int)__hip_atomic_load(gcnt + 64 * e, __ATOMIC_RELAXED, __HIP_MEMORY_SCOPE_AGENT)); pre[e] = a; a += (cnt[e] + 255) >> 8; }
        pre[16] = a;
    }
    __device__ __forceinline__ bool next(int i, Unit& u) const {
        const int L = i * G + c, rt = L >> 2; if (rt >= pre[16]) return false;
        int e = 0, pe = 0;
#pragma unroll
        for (int k = 1; k < 16; ++k) if (rt >= pre[k]) { e = k; pe = pre[k]; }
        u.pm = rt; u.pn = e * 4 + (L & 3); u.e = e; u.lt = rt - pe; return true;
    }
    __device__ __forceinline__ void a_ready(const Unit&) const {}
    __device__ __forceinline__ void done(const Unit&) const {}
    __device__ __forceinline__ void gather(const Unit& u, const int (&RA)[2], const int (&CA)[2], int K, unsigned (&v)[2][2]) const {
        int ce = 1;
#pragma unroll
        for (int k = 0; k < 16; ++k) if (u.e == k) ce = cnt[k];
        const int* lp = list + u.e * 16384;
#pragma unroll
        for (int h = 0; h < 2; ++h)
#pragma unroll
            for (int i = 0; i < 2; ++i) { int pos = u.lt * 256 + h * HALF + RA[i]; pos = pos < ce ? pos : ce - 1; const int tok = lp[pos]; v[h][i] = (unsigned)(tok * K + CA[i]) * 2u; }
#pragma unroll
        for (int h = 0; h < 2; ++h)
#pragma unroll
            for (int i = 0; i < 2; ++i) asm volatile("" : "+v"(v[h][i]) :: "memory");
    }
};
template <class Epi, class Sched, bool ALIGN_EPI = false, bool SP2 = false, bool GATHER = false>
__device__ __forceinline__ void gemm_phase(PG8_LAS unsigned char* lds, const Gemm g, const Sched& S, const Epi& E, int wave_id  ) {
    int lane; asm volatile("v_mbcnt_lo_u32_b32 %0, -1, 0\n\tv_mbcnt_hi_u32_b32 %0, -1, %0" : "=v"(lane));
    const int wid = wave_id, tid = wid * 64 + lane, wr = wid >> 2, wc = wid & 3, fr = lane & 15, fq = lane >> 4;
    const int K = g.K, nt = K / BK;
    unsigned vc[2][2], vn[2][2], voffB[2]; int RA[2], CA[2];
#pragma unroll
    for (int i = 0; i < 2; ++i) { int R, C; stage_rc(tid * 16 + i * 8192, R, C); const int Rb = Epi::PERM ? ((R & ~31) + perm32(R & 31)) : R; RA[i] = R; CA[i] = C;
        vc[0][i] = (unsigned)(R * K + C) * 2u; vc[1][i] = (unsigned)((R + HALF) * K + C) * 2u; vn[0][i] = vc[0][i]; vn[1][i] = vc[1][i]; voffB[i] = (unsigned)(Rb * K + C) * 2u; }
    const size_t kstep = (size_t)(BK * 2);
    const size_t hstep = (size_t)HALF * K * 2;
    const size_t tstep = 2 * hstep;
    const unsigned ldsw = (unsigned)wid * 1024u;
    const int aoff = lds_byte(wr * 64 + fr, fq * 8), boff = lds_byte(wc * 32 + fr, fq * 8);
#define PG8_SA(b, h) (((b) * 2 + (h)) * HTB)
#define PG8_AP(p, h) ((p) + (GATHER ? (size_t)0 : (size_t)(h) * hstep))
#define PG8_AV(X, h) (GATHER ? X[h] : vc[0])
#define PG8_SB(b, h) ((4 + (b) * 2 + (h)) * HTB)
#define PG8_STAGE(bufoff, gbase, voff) do { _Pragma("unroll") for (int _i = 0; _i < 2; ++_i) \
        __builtin_amdgcn_global_load_lds((const unsigned*)((const char*)(gbase) + (voff)[_i]), (PG8_LAS unsigned*)(lds + (bufoff) + ldsw + _i * 8192), 16, 0, 0); } while (0)
#define PG8_LDA(dst, b, h) do { _Pragma("unroll") for (int m = 0; m < 4; ++m) _Pragma("unroll") for (int k = 0; k < 2; ++k) dst[m][k] = *(const PG8_LAS bf16x8*)(lds + PG8_SA(b, h) + aoff + m * 2048 + k * 1024); } while (0)
#define PG8_LDB(dst, b, h) do { _Pragma("unroll") for (int n = 0; n < 2; ++n) _Pragma("unroll") for (int k = 0; k < 2; ++k) dst[n][k] = *(const PG8_LAS bf16x8*)(lds + PG8_SB(b, h) + boff + n * 2048 + k * 1024); } while (0)
#define PG8_MMA(ai, bj, At, Bt) do { __builtin_amdgcn_s_setprio(1); _Pragma("unroll") for (int m = 0; m < 4; ++m) _Pragma("unroll") for (int n = 0; n < 2; ++n) _Pragma("unroll") for (int k = 0; k < 2; ++k) \
        acc[ai][bj][m][n] = __builtin_amdgcn_mfma_f32_16x16x32_bf16(Bt[n][k], At[m][k], acc[ai][bj][m][n], 0, 0, 0); __builtin_amdgcn_s_setprio(0); } while (0)
#define PG8_WAIT_V(n) asm volatile("s_waitcnt vmcnt(" #n ")" ::: "memory")
#define PG8_WAIT_L(n) asm volatile("s_waitcnt lgkmcnt(" #n ")" ::: "memory")
#define PG8_BAR __builtin_amdgcn_s_barrier()
#define PG8_SCHED __builtin_amdgcn_sched_barrier(0)
    Unit cur, nxt; int ui = 0;
    if (!S.next(0, cur)) return;
    f32x4 acc[2][2][4][2];
#pragma unroll
    for (int a = 0; a < 2; ++a)
#pragma unroll
        for (int b = 0; b < 2; ++b)
#pragma unroll
            for (int m = 0; m < 4; ++m)
#pragma unroll
                for (int n = 0; n < 2; ++n) acc[a][b][m][n] = (f32x4){0.f, 0.f, 0.f, 0.f};
    bf16x8 At[4][2], B0[2][2], B1[2][2];
    const char* cA = (const char*)g.A + (GATHER ? (size_t)0 : (size_t)cur.pm * tstep); const char* cB = (const char*)g.Bt + (size_t)cur.pn * tstep;
    if constexpr (GATHER) S.gather(cur, RA, CA, K, vc);
    S.a_ready(cur);
    if constexpr (SP2) {
        PG8_STAGE(PG8_SB(0, 0), cB, voffB); PG8_STAGE(PG8_SB(0, 1), cB + hstep, voffB); PG8_STAGE(PG8_SA(0, 0), PG8_AP(cA, 0), PG8_AV(vc, 0)); PG8_STAGE(PG8_SA(0, 1), PG8_AP(cA, 1), PG8_AV(vc, 1));
        if (wr == 1) PG8_BAR;
        PG8_WAIT_V(2); PG8_BAR;
        PG8_STAGE(PG8_SB(1, 0), cB + kstep, voffB); PG8_STAGE(PG8_SA(1, 0), PG8_AP(cA + kstep, 0), PG8_AV(vc, 0)); PG8_STAGE(PG8_SB(1, 1), cB + hstep + kstep, voffB);
        PG8_WAIT_V(6); PG8_BAR;
    } else {
        PG8_STAGE(PG8_SB(0, 0), cB, voffB); PG8_STAGE(PG8_SA(0, 0), PG8_AP(cA, 0), PG8_AV(vc, 0)); PG8_STAGE(PG8_SB(0, 1), cB + hstep, voffB); PG8_STAGE(PG8_SA(0, 1), PG8_AP(cA, 1), PG8_AV(vc, 1));
        if (wr == 1) PG8_BAR;
        PG8_WAIT_V(4); PG8_BAR;
        PG8_STAGE(PG8_SB(1, 0), cB + kstep, voffB); PG8_STAGE(PG8_SA(1, 0), PG8_AP(cA + kstep, 0), PG8_AV(vc, 0)); PG8_STAGE(PG8_SB(1, 1), cB + hstep + kstep, voffB);
        PG8_WAIT_V(6); PG8_BAR;
    }
    for (;;) {
        const bool has_next = S.next(ui + 1, nxt);
        const char* nA = (has_next && !GATHER) ? (const char*)g.A + (size_t)nxt.pm * tstep : cA; const char* nB = has_next ? (const char*)g.Bt + (size_t)nxt.pn * tstep : cB;
        if constexpr (GATHER) { if (has_next) S.gather(nxt, RA, CA, K, vn); else {
#pragma unroll
            for (int h_ = 0; h_ < 2; ++h_)
#pragma unroll
                for (int i_ = 0; i_ < 2; ++i_) vn[h_][i_] = vc[h_][i_]; } }
        for (int t = 0; t < nt; t += 2) {
            const bool last = (t == nt - 2);
            const char* a1 = cA + (size_t)(t + 1) * kstep;
            const char* a2 = last ? nA : cA + (size_t)(t + 2) * kstep; const char* b2 = last ? nB : cB + (size_t)(t + 2) * kstep;
            const char* a3 = a2 + kstep; const char* b3 = b2 + kstep;
            unsigned s2[2][2];
#pragma unroll
            for (int h_ = 0; h_ < 2; ++h_)
#pragma unroll
                for (int i_ = 0; i_ < 2; ++i_) s2[h_][i_] = (GATHER && last) ? vn[h_][i_] : vc[h_][i_];
            if (last && has_next) S.a_ready(nxt);
            if constexpr (SP2) {
            PG8_LDB(B0, 0, 0); PG8_LDB(B1, 0, 1); PG8_SCHED; PG8_LDA(At, 0, 0); PG8_STAGE(PG8_SA(1, 1), PG8_AP(a1, 1), PG8_AV(vc, 1));
            PG8_WAIT_V(8); PG8_WAIT_L(0); PG8_BAR; PG8_MMA(0, 0, At, B0); PG8_MMA(0, 1, At, B1); PG8_BAR; PG8_SCHED;
            PG8_LDA(At, 0, 1); PG8_STAGE(PG8_SB(0, 0), b2, voffB); PG8_STAGE(PG8_SB(0, 1), b2 + hstep, voffB); PG8_STAGE(PG8_SA(0, 0), PG8_AP(a2, 0), PG8_AV(s2, 0));
            PG8_WAIT_V(8); PG8_WAIT_L(0); PG8_BAR; PG8_MMA(1, 0, At, B0); PG8_MMA(1, 1, At, B1); PG8_BAR; PG8_SCHED;
            PG8_LDB(B0, 1, 0); PG8_LDB(B1, 1, 1); PG8_SCHED; PG8_LDA(At, 1, 0); PG8_STAGE(PG8_SA(0, 1), PG8_AP(a2, 1), PG8_AV(s2, 1));
            PG8_WAIT_V(8); PG8_WAIT_L(0); PG8_BAR; PG8_MMA(0, 0, At, B0); PG8_MMA(0, 1, At, B1); PG8_BAR; PG8_SCHED;
            PG8_LDA(At, 1, 1); PG8_STAGE(PG8_SB(1, 0), b3, voffB); PG8_STAGE(PG8_SB(1, 1), b3 + hstep, voffB); PG8_STAGE(PG8_SA(1, 0), PG8_AP(a3, 0), PG8_AV(s2, 0));
            PG8_WAIT_V(8); PG8_WAIT_L(0); PG8_BAR; PG8_MMA(1, 0, At, B0); PG8_MMA(1, 1, At, B1); PG8_BAR; PG8_SCHED;
            } else {
            PG8_LDB(B0, 0, 0); PG8_SCHED; PG8_LDA(At, 0, 0); PG8_STAGE(PG8_SA(1, 1), PG8_AP(a1, 1), PG8_AV(vc, 1));
            PG8_WAIT_L(8); PG8_BAR; PG8_WAIT_L(0); PG8_MMA(0, 0, At, B0); PG8_BAR; PG8_SCHED;
            PG8_LDB(B1, 0, 1); PG8_STAGE(PG8_SB(0, 0), b2, voffB);
            PG8_BAR; PG8_WAIT_L(0); PG8_MMA(0, 1, At, B1); PG8_BAR;
            PG8_LDA(At, 0, 1); PG8_STAGE(PG8_SA(0, 0), PG8_AP(a2, 0), PG8_AV(s2, 0));
            PG8_BAR; PG8_WAIT_L(0); PG8_MMA(1, 0, At, B0); PG8_BAR; PG8_SCHED;
            PG8_STAGE(PG8_SB(0, 1), b2 + hstep, voffB);
            PG8_WAIT_V(6); PG8_BAR; PG8_MMA(1, 1, At, B1); PG8_BAR;
            PG8_LDB(B0, 1, 0); PG8_SCHED; PG8_LDA(At, 1, 0); PG8_STAGE(PG8_SA(0, 1), PG8_AP(a2, 1), PG8_AV(s2, 1));
            PG8_WAIT_L(8); PG8_BAR; PG8_WAIT_L(0); PG8_MMA(0, 0, At, B0); PG8_BAR; PG8_SCHED;
            PG8_LDB(B1, 1, 1); PG8_STAGE(PG8_SB(1, 0), b3, voffB);
            PG8_BAR; PG8_WAIT_L(0); PG8_MMA(0, 1, At, B1); PG8_BAR;
            PG8_LDA(At, 1, 1); PG8_STAGE(PG8_SA(1, 0), PG8_AP(a3, 0), PG8_AV(s2, 0));
            PG8_BAR; PG8_WAIT_L(0); PG8_MMA(1, 0, At, B0); PG8_BAR; PG8_SCHED;
            PG8_STAGE(PG8_SB(1, 1), b3 + hstep, voffB);
            PG8_WAIT_V(6); PG8_BAR; PG8_MMA(1, 1, At, B1); PG8_BAR;
            }
        }
        if constexpr (ALIGN_EPI) { if (wr == 0) PG8_BAR; }
        if constexpr (!Epi::AFTER_DRAIN) { E(acc, cur, wr, wc, fr, fq); S.done(cur); }
        if (!has_next) break;
#pragma unroll
        for (int a = 0; a < 2; ++a)
#pragma unroll
            for (int b = 0; b < 2; ++b)
#pragma unroll
                for (int m = 0; m < 4; ++m)
#pragma unroll
                    for (int n = 0; n < 2; ++n) acc[a][b][m][n] = (f32x4){0.f, 0.f, 0.f, 0.f};
        cur = nxt; cA = nA; cB = nB; ++ui;
        if constexpr (GATHER) {
#pragma unroll
            for (int h_ = 0; h_ < 2; ++h_)
#pragma unroll
                for (int i_ = 0; i_ < 2; ++i_) vc[h_][i_] = vn[h_][i_]; }
        if constexpr (ALIGN_EPI) { if (wr == 1) PG8_BAR; }
    }
    PG8_WAIT_V(0);
    if constexpr (!ALIGN_EPI) { if (wr == 0) PG8_BAR; }
    PG8_BAR;
    if constexpr (Epi::AFTER_DRAIN) { E.fused(acc, cur, wr, wc, fr, fq, lds, wid, lane); S.done(cur); }
#undef PG8_SA
#undef PG8_AP
#undef PG8_AV
#undef PG8_SB
#undef PG8_STAGE
#undef PG8_LDA
#undef PG8_LDB
#undef PG8_MMA
#undef PG8_WAIT_V
#undef PG8_WAIT_L
#undef PG8_BAR
#undef PG8_SCHED
}
}

constexpr int NB = 2, T = 8192, D = 1024, M = NB * T;
constexpr int NPROJ = 3072, NEXP = 16, DEXP = 512, NMETA = 16;
constexpr float EPS = 1e-6f, LOG2E = 1.4426950408889634f;
constexpr float C2 = 0.125f * LOG2E;
constexpr float LAMBDA_INIT = 0.2f;
constexpr int SLOT_ROWS = 36864;

constexpr size_t MiB = 1u << 20;
constexpr size_t WS_CTL = 0, CTL_ZERO_BYTES = 1 * MiB;
constexpr size_t WS_WIN = 2 * MiB, WS_WOUT = 8 * MiB, WS_WGU = 10 * MiB, WS_WD = 42 * MiB;
constexpr size_t WS_HN = 58 * MiB;
constexpr size_t WS_QD = 90 * MiB, WS_KD = 106 * MiB, WS_VD = 122 * MiB, WS_QS = 138 * MiB, WS_KS = 154 * MiB, WS_VS = 170 * MiB;
constexpr size_t WS_HN2 = 90 * MiB;
constexpr size_t WS_HID = 122 * MiB;
constexpr size_t WS_Y = 158 * MiB;
constexpr size_t WS_META = 232 * MiB;
constexpr size_t WS_LIST = 233 * MiB;
constexpr size_t WS_TOKE = 234 * MiB;
constexpr size_t WS_TOKW = 235 * MiB;
constexpr size_t WS_END = 256 * MiB;
static_assert(WS_HID + (size_t)SLOT_ROWS * 512 * 2 <= WS_Y && WS_Y + (size_t)SLOT_ROWS * 1024 * 2 <= WS_META, "d_ws map");
constexpr int CW_TMO = 0, CW_CNT = 1024  , CW_BAR = 4096;

constexpr int RING_OFF = 0, RING_BYTES = 131072;
constexpr int LDSCTL_OFF = RING_BYTES, MISC_OFF = LDSCTL_OFF + 320;
constexpr int LDS_BYTES = 147456;
constexpr int NWAVES = 8;

#define GAS __attribute__((address_space(1)))
#define LAS __attribute__((address_space(3)))
typedef unsigned short bf16;
typedef unsigned v4u __attribute__((ext_vector_type(4)));
typedef unsigned v2u __attribute__((ext_vector_type(2)));
typedef float f32x4 __attribute__((ext_vector_type(4)));
typedef short bf16x8 __attribute__((ext_vector_type(8)));
typedef GAS unsigned gu32;
typedef GAS unsigned long long gu64;
#define RLX_AGENT __ATOMIC_RELAXED, __HIP_MEMORY_SCOPE_AGENT
#define LDS_WAIT() asm volatile("s_waitcnt lgkmcnt(0)" ::: "memory")
#define VM_WAIT() asm volatile("s_waitcnt vmcnt(0)" ::: "memory")
__device__ __forceinline__ unsigned f2bf(float f) { unsigned u = __builtin_bit_cast(unsigned, f); return (u + 0x7fffu + ((u >> 16) & 1u)) >> 16; }
__device__ __forceinline__ unsigned pk2(float lo, float hi) { return f2bf(lo) | (f2bf(hi) << 16); }
__device__ __forceinline__ float bf2f(unsigned short h) { return __builtin_bit_cast(float, (unsigned)h << 16); }
#define XB_TMO      128
#define XB_XCNT(j)  (256  + 64 * (j))
#define XB_XSUB(j)  (1280 + 64 * (j))
#define XB_XGEN(j)  (2304 + 64 * (j))
#define XB_TOP      3328
#define XB_TOPGEN   3392
#define XCD_BAR_WORDS 3456
#define XB_SPIN_CAP (1u << 18)

__device__ __forceinline__ unsigned xb_ld(unsigned* p)              { return __hip_atomic_load(p, __ATOMIC_RELAXED, __HIP_MEMORY_SCOPE_AGENT); }
__device__ __forceinline__ unsigned xb_add(unsigned* p, unsigned v) { return __hip_atomic_fetch_add(p, v, __ATOMIC_RELAXED, __HIP_MEMORY_SCOPE_AGENT); }
__device__ __forceinline__ unsigned xb_xcc_id() { return (unsigned)__builtin_amdgcn_s_getreg((3 << 11) | 20) & 0xFu; }
#define XB_SPIN(cond, bar) do { unsigned _sp = 0; while (cond) { __builtin_amdgcn_s_sleep(1); \
    if ((++_sp & 255u) == 0u) { if (xb_ld(&(bar)[XB_TMO])) break; if (_sp > XB_SPIN_CAP) { atomicAdd(&(bar)[XB_TMO], 1u); break; } } } } while (0)

struct XcdBarrier {
    unsigned* bar; unsigned x;
    volatile LAS unsigned* st;
};

__device__ __forceinline__ XcdBarrier xcd_barrier_post(unsigned* bar, volatile LAS unsigned* st, int tid) {
    XcdBarrier b; b.bar = bar; b.x = xb_xcc_id(); b.st = st;
    if (tid == 0) (void)xb_add(&bar[XB_XCNT(b.x)], 1u);
    return b;
}
__device__ __forceinline__ void xcd_barrier_complete(unsigned* bar, unsigned x, unsigned& nloc, unsigned& nx) {
    const unsigned G = gridDim.x * gridDim.y * gridDim.z;
    unsigned sum, cnt, mine, sp = 0u;
    for (;;) {
        sum = 0u; cnt = 0u; mine = 0u;
#pragma unroll
        for (unsigned j = 0; j < 16; ++j) { const unsigned c = xb_ld(&bar[XB_XCNT(j)]); sum += c; cnt += (c > 0u) ? 1u : 0u; mine = (j == x) ? c : mine; }
        if (sum == G) break;
        __builtin_amdgcn_s_sleep(1);
        if ((++sp & 255u) == 0u) { if (xb_ld(&bar[XB_TMO])) break; if (sp > XB_SPIN_CAP) { atomicAdd(&bar[XB_TMO], 1u); break; } }
    }
    nloc = mine > 0u ? mine : 1u; nx = cnt > 0u ? cnt : 1u;
}

__device__ __forceinline__ void xcd_barrier(const XcdBarrier& b, int tid  ) {
    asm volatile("s_waitcnt vmcnt(0)" ::: "memory");
    __syncthreads();
    if (tid == 0) {
        unsigned* bar = b.bar;
        __builtin_amdgcn_s_waitcnt(0);
        unsigned nloc = b.st[0], nx = b.st[1];
        if (nloc == 0u) { xcd_barrier_complete(bar, b.x, nloc, nx); b.st[0] = nloc; b.st[1] = nx; }
        const unsigned old = xb_add(&bar[XB_XSUB(b.x)], 1u);
        const unsigned gen = old / nloc;
        if (old + 1u == (gen + 1u) * nloc) {
            __builtin_amdgcn_fence(__ATOMIC_RELEASE, "agent");
            asm volatile("s_waitcnt vmcnt(0)" ::: "memory");
            const unsigned og = xb_add(&bar[XB_TOP], 1u);
            const unsigned tg = og / nx;
            if (og + 1u == (tg + 1u) * nx) xb_add(&bar[XB_TOPGEN], 1u);
            else XB_SPIN(xb_ld(&bar[XB_TOPGEN]) == tg, bar);
            __builtin_amdgcn_fence(__ATOMIC_ACQUIRE, "agent");
            xb_add(&bar[XB_XGEN(b.x)], 1u);
            asm volatile("s_waitcnt vmcnt(0)" ::: "memory");
        } else {
            XB_SPIN(xb_ld(&bar[XB_XGEN(b.x)]) == gen, bar);
            __builtin_amdgcn_fence(__ATOMIC_ACQUIRE, "agent");
            asm volatile("s_waitcnt vmcnt(0)" ::: "memory");
        }
    }
    __syncthreads();
}

__device__ __forceinline__ int lane_now() { int x; asm volatile("v_mbcnt_lo_u32_b32 %0, -1, 0\n\tv_mbcnt_hi_u32_b32 %0, -1, %0" : "=v"(x)); return x; }
#define LANE_TID(F) const int lane_ = lane_now(), tid_ = (F).wave * 64 + lane_; (void)tid_
struct Frame {
    LAS unsigned char* lds;
    volatile LAS unsigned* MISC;
    gu32* ctl;
    int wave, vcu, G;
    const float *x, *meta, *rel_table, *attn_norm, *w_in, *lq1, *lk1, *lq2, *lk2, *diff_norm, *sb_norm, *w_out, *ffn_norm, *w_group, *w_router, *w_gate, *w_up, *w_down, *final_norm;
    float* out;
    bf16 *Win_t, *Wout_t, *Wgu_t, *Wd_t;
    bf16 *HN, *MIX, *QD, *KD, *VD, *QS, *KS, *VS, *HN2, *HID, *Y, *KDM, *VDM, *KSM, *VSM;
    int* list; int* toke; float* tokw;
};

__device__ __forceinline__ float wave_sum(float v) {
#pragma unroll
    for (int o = 1; o < 64; o <<= 1) v += __shfl_xor(v, o);
    return v;
}
__device__ __forceinline__ void p0_transpose_item(const float* W, int K, int N, bf16* WT, int drow0, LAS float* scr, int k0, int n0, int lane) {
    f32x4 v[8];
#pragma unroll
    for (int i = 0; i < 8; ++i) v[i] = *(const GAS f32x4*)(W + (size_t)(k0 + 8 * i + (lane >> 3)) * N + n0 + 4 * (lane & 7));
#pragma unroll
    for (int i = 0; i < 8; ++i) { LAS float* d = scr + (8 * i + (lane >> 3)) * 33 + 4 * (lane & 7); d[0] = v[i].x; d[1] = v[i].y; d[2] = v[i].z; d[3] = v[i].w; }
    LDS_WAIT(); asm volatile("" ::: "memory");
    const int c = lane & 7;
#pragma unroll
    for (int j = 0; j < 4; ++j) { const int n = (lane >> 3) + 8 * j; const LAS float* s = scr + (8 * c) * 33 + n;
        v4u o; o.x = pk2(s[0 * 33], s[1 * 33]); o.y = pk2(s[2 * 33], s[3 * 33]); o.z = pk2(s[4 * 33], s[5 * 33]); o.w = pk2(s[6 * 33], s[7 * 33]);
        *(GAS v4u*)(WT + (size_t)(drow0 + n) * K + k0 + 8 * c) = o; }
    LDS_WAIT(); asm volatile("" ::: "memory");
}
__device__ __forceinline__ void rms_row_to_bf16(int lane, const float* xrow, const float* gain, bf16* orow) {
    const GAS f32x4* xr = (const GAS f32x4*)xrow + lane; const GAS f32x4* gr = (const GAS f32x4*)gain + lane;
    f32x4 v[4]; float s = 0.f;
#pragma unroll
    for (int j = 0; j < 4; ++j) { v[j] = xr[64 * j]; s += (v[j].x * v[j].x + v[j].y * v[j].y) + (v[j].z * v[j].z + v[j].w * v[j].w); }
    const float rstd = 1.f / sqrtf(wave_sum(s) * (1.f / D) + EPS);
    GAS unsigned long long* o8 = (GAS unsigned long long*)orow + lane;
#pragma unroll
    for (int j = 0; j < 4; ++j) { const f32x4 g = gr[64 * j]; o8[64 * j] = (unsigned long long)pk2(v[j].x * rstd * g.x, v[j].y * rstd * g.y) | ((unsigned long long)pk2(v[j].z * rstd * g.z, v[j].w * rstd * g.w) << 32); }
}
__device__ __forceinline__ bf16* meta_addr(Frame& F, int col, int key) {
    const int sec = col >> 9, cc = col & 511;
    if (sec == 1) { const int h = cc >> 7, s = (cc >> 6) & 1, ch = (cc & 63) >> 3; return F.KDM + (h * 2 + s) * 4096 + ch * 512 + key * 8 + (cc & 7); }
    if (sec == 2) { const int h = cc >> 7, d = cc & 127; return F.VDM + h * 8192 + (d >> 5) * 2048 + key * 32 + (d & 31); }
    if (sec == 4) { const int h = cc >> 6, ch = (cc & 63) >> 3; return F.KSM + h * 4096 + ch * 512 + key * 8 + (cc & 7); }
    if (sec == 5) { const int h = cc >> 6, d = cc & 63; return F.VSM + h * 4096 + (d >> 5) * 2048 + key * 32 + (d & 31); }
    return nullptr;
}
__device__ __forceinline__ void p0_prologue(Frame& F) {
    LANE_TID(F);
    const int gw = F.vcu * NWAVES + F.wave, NGW = F.G * NWAVES;
    for (int it = blockIdx.x; it < 256; it += F.G) {
        const int sec = it >> 6, colbase = (sec == 0 ? 512 : sec == 1 ? 1024 : sec == 2 ? 2048 : 2560) + (it & 63) * 8;
        LAS float* hnm = (LAS float*)(F.lds + RING_OFF);
        LAS float* red = (LAS float*)(F.lds + RING_OFF + 65536);
        for (int r = F.wave * 2; r < F.wave * 2 + 2; ++r) {
            const GAS f32x4* xr = (const GAS f32x4*)(F.meta + (size_t)r * D) + lane_; const GAS f32x4* gr = (const GAS f32x4*)F.attn_norm + lane_;
            f32x4 v[4]; float s = 0.f;
#pragma unroll
            for (int j = 0; j < 4; ++j) { v[j] = xr[64 * j]; s += (v[j].x * v[j].x + v[j].y * v[j].y) + (v[j].z * v[j].z + v[j].w * v[j].w); }
            const float rstd = 1.f / sqrtf(wave_sum(s) * (1.f / D) + EPS);
#pragma unroll
            for (int j = 0; j < 4; ++j) { const f32x4 g = gr[64 * j]; *(LAS f32x4*)(hnm + r * D + 256 * j + 4 * lane_) = v[j] * rstd * g; }
        }
        const int c = lane_ & 7, kg = lane_ >> 3, kb = F.wave * 128 + kg;
        float wv[16];
#pragma unroll
        for (int i = 0; i < 16; ++i) wv[i] = F.w_in[(size_t)(kb + 8 * i) * NPROJ + colbase + c];
        __syncthreads();
        float acc[16];
#pragma unroll
        for (int m = 0; m < 16; ++m) { float a = 0.f;
#pragma unroll
            for (int i = 0; i < 16; ++i) a += hnm[m * D + kb + 8 * i] * wv[i];
            a += __shfl_xor(a, 8); a += __shfl_xor(a, 16); a += __shfl_xor(a, 32); acc[m] = a; }
        if (kg == 0) {
#pragma unroll
            for (int m = 0; m < 16; ++m) red[(F.wave * 16 + m) * 8 + c] = acc[m]; }
        __syncthreads();
        if (tid_ < 128) { const int m = tid_ >> 3, cc = tid_ & 7; float s = 0.f;
#pragma unroll
            for (int w = 0; w < 8; ++w) s += red[(w * 16 + m) * 8 + cc];
            *meta_addr(F, colbase + cc, m) = (bf16)f2bf(s); }
        if (tid_ < 384) { const int key = 16 + (tid_ >> 3), cc = tid_ & 7; *meta_addr(F, colbase + cc, key) = (bf16)0; }
        __syncthreads();
    }
    LAS float* scr = (LAS float*)(F.lds + RING_OFF + F.wave * 16384);
    constexpr int I_IN = 16 * 96, I_OUT = 16 * 32, I_G = 16 * 256, I_D = 16 * 256, NITEMS = I_IN + I_OUT + 2 * I_G + I_D;
    for (int it = gw; it < NITEMS; it += NGW) {
        int r = it;
        if (r < I_IN) { p0_transpose_item(F.w_in, D, NPROJ, F.Win_t, 32 * (r % 96), scr, 64 * (r / 96), 32 * (r % 96), lane_); continue; } r -= I_IN;
        if (r < I_OUT) { p0_transpose_item(F.w_out, D, D, F.Wout_t, 32 * (r % 32), scr, 64 * (r / 32), 32 * (r % 32), lane_); continue; } r -= I_OUT;
        if (r < 2 * I_G) { const int up = r >= I_G; if (up) r -= I_G; const int e = r >> 8, q = r & 255, n0 = 32 * (q % 16), k0 = 64 * (q / 16);
            p0_transpose_item((up ? F.w_up : F.w_gate) + (size_t)e * D * DEXP, D, DEXP, F.Wgu_t + (size_t)e * 1024 * D, (n0 >> 7) * 256 + up * 128 + (n0 & 127), scr, k0, n0, lane_); continue; } r -= 2 * I_G;
        { const int e = r >> 8, q = r & 255, n0 = 32 * (q % 32), k0 = 64 * (q / 32);
            p0_transpose_item(F.w_down + (size_t)e * DEXP * D, DEXP, D, F.Wd_t + (size_t)e * D * DEXP, n0, scr, k0, n0, lane_); }
    }
    for (int m = gw; m < M; m += NGW) rms_row_to_bf16(lane_, F.x + (size_t)m * D, F.attn_norm, F.HN + (size_t)m * D);
}

template <int CTRL> __device__ __forceinline__ float dpp_rot_add(float v) { return v + __builtin_bit_cast(float, __builtin_amdgcn_update_dpp(0, __builtin_bit_cast(int, v), CTRL, 0xf, 0xf, false)); }
__device__ __forceinline__ float wave_sum_u(float v) {
    v = dpp_rot_add<0x128>(v); v = dpp_rot_add<0x124>(v); v = dpp_rot_add<0x122>(v); v = dpp_rot_add<0x121>(v);
    v += __shfl_xor(v, 16); v += __shfl_xor(v, 32);
    return v;
}
__device__ __forceinline__ void p4_route(Frame& F, bool dry = false  ) {
    LANE_TID(F);
    LAS float* wl = (LAS float*)(F.lds + RING_OFF);
    LAS int* lcnt = (LAS int*)(F.lds + RING_OFF + 81920);
    LAS int* lbase = lcnt + 16;
    LAS int* rinfo = lcnt + 64;
    LAS float* rw = (LAS float*)(rinfo + 256);
    for (int k = tid_; k < 1024; k += NWAVES * 64) {
        const int slot = ((k >> 8) * 4 + (k & 3)) * 64 + ((k >> 2) & 63);
        LAS f32x4* dst = (LAS f32x4*)(wl + slot * 20);
        dst[0] = *(const GAS f32x4*)(F.w_group + k * 4);
#pragma unroll
        for (int q = 0; q < 4; ++q) dst[1 + q] = *(const GAS f32x4*)(F.w_router + k * 16 + 4 * q);
    }
    const GAS f32x4* gr = (const GAS f32x4*)F.ffn_norm + lane_;
    f32x4 g[4];
#pragma unroll
    for (int j = 0; j < 4; ++j) g[j] = gr[64 * j];
    for (int blk = blockIdx.x; blk < M / 64; blk += F.G) {
        if (tid_ < 16) lcnt[tid_] = 0;
        __syncthreads();
#pragma unroll 1
        for (int part = 0; part < 4; ++part) {
            const int lr0 = F.wave * 8 + part * 2, m0 = blk * 64 + lr0;
            f32x4 v[2][4]; float rstd[2];
#pragma unroll
            for (int rr = 0; rr < 2; ++rr) { const GAS f32x4* xr = (const GAS f32x4*)(F.out + (size_t)(m0 + rr) * D) + lane_;
#pragma unroll
                for (int j = 0; j < 4; ++j) v[rr][j] = xr[64 * j]; }
#pragma unroll
            for (int rr = 0; rr < 2; ++rr) { float s = 0.f;
#pragma unroll
                for (int j = 0; j < 4; ++j) s += (v[rr][j].x * v[rr][j].x + v[rr][j].y * v[rr][j].y) + (v[rr][j].z * v[rr][j].z + v[rr][j].w * v[rr][j].w);
                rstd[rr] = 1.f / sqrtf(wave_sum_u(s) * (1.f / D) + EPS); }
#pragma unroll
            for (int rr = 0; rr < 2; ++rr) { GAS unsigned long long* o8 = (GAS unsigned long long*)(F.HN2 + (size_t)(m0 + rr) * D) + lane_;
#pragma unroll
                for (int j = 0; j < 4; ++j) { v[rr][j] = v[rr][j] * rstd[rr] * g[j]; o8[64 * j] = (unsigned long long)pk2(v[rr][j].x, v[rr][j].y) | ((unsigned long long)pk2(v[rr][j].z, v[rr][j].w) << 32); } }
            float lg[2][20];
            const int lw_ = lane_now();
#pragma unroll
            for (int rr = 0; rr < 2; ++rr)
#pragma unroll
                for (int o = 0; o < 20; ++o) lg[rr][o] = 0.f;
#pragma unroll
            for (int j = 0; j < 4; ++j) {
#pragma unroll
                for (int e = 0; e < 4; ++e) { const LAS f32x4* wp = (const LAS f32x4*)(wl + ((j * 4 + e) * 64 + lw_) * 20);
#pragma unroll
                    for (int q = 0; q < 5; ++q) { const f32x4 w4 = wp[q];
#pragma unroll
                        for (int rr = 0; rr < 2; ++rr) { const float xv = v[rr][j][e]; lg[rr][4 * q + 0] += xv * w4.x; lg[rr][4 * q + 1] += xv * w4.y; lg[rr][4 * q + 2] += xv * w4.z; lg[rr][4 * q + 3] += xv * w4.w; } }
                    __builtin_amdgcn_sched_barrier(0); }
            }
#pragma unroll
            for (int rr = 0; rr < 2; ++rr)
                asm volatile("" : "+v"(lg[rr][0]), "+v"(lg[rr][1]), "+v"(lg[rr][2]), "+v"(lg[rr][3]), "+v"(lg[rr][4]), "+v"(lg[rr][5]), "+v"(lg[rr][6]), "+v"(lg[rr][7]), "+v"(lg[rr][8]), "+v"(lg[rr][9]),
                             "+v"(lg[rr][10]), "+v"(lg[rr][11]), "+v"(lg[rr][12]), "+v"(lg[rr][13]), "+v"(lg[rr][14]), "+v"(lg[rr][15]), "+v"(lg[rr][16]), "+v"(lg[rr][17]), "+v"(lg[rr][18]), "+v"(lg[rr][19]));
#pragma unroll
            for (int rr = 0; rr < 2; ++rr) {
#pragma unroll
                for (int o = 0; o < 20; ++o) lg[rr][o] = wave_sum_u(lg[rr][o]);
                int gi = 0; float gm = lg[rr][0];
#pragma unroll
                for (int o = 1; o < 4; ++o) if (lg[rr][o] > gm) { gm = lg[rr][o]; gi = o; }
                float gs = 0.f;
#pragma unroll
                for (int o = 0; o < 4; ++o) gs += __expf(lg[rr][o] - gm);
                const float gw_ = 1.f / gs;
                float el[4];
#pragma unroll
                for (int o = 0; o < 4; ++o) el[o] = gi == 0 ? lg[rr][4 + o] : gi == 1 ? lg[rr][8 + o] : gi == 2 ? lg[rr][12 + o] : lg[rr][16 + o];
                int i1 = 0; float m1 = el[0];
#pragma unroll
                for (int o = 1; o < 4; ++o) if (el[o] > m1) { m1 = el[o]; i1 = o; }
                int i2 = -1; float m2 = -3.0e38f;
#pragma unroll
                for (int o = 0; o < 4; ++o) if (o != i1 && el[o] > m2) { m2 = el[o]; i2 = o; }
                const float w1 = 1.f / (1.f + __expf(m2 - m1)), w2 = 1.f - w1;
                if (lane_ == 0) { const int lr = lr0 + rr, ea = gi * 4 + i1, eb = gi * 4 + i2;
                    rinfo[lr * 4 + 0] = ea; rinfo[lr * 4 + 1] = eb; rinfo[lr * 4 + 2] = __hip_atomic_fetch_add(&lcnt[ea], 1, __ATOMIC_RELAXED, __HIP_MEMORY_SCOPE_WORKGROUP); rinfo[lr * 4 + 3] = __hip_atomic_fetch_add(&lcnt[eb], 1, __ATOMIC_RELAXED, __HIP_MEMORY_SCOPE_WORKGROUP);
                    rw[lr * 2 + 0] = gw_ * w1; rw[lr * 2 + 1] = gw_ * w2; }
            }
        }
        __syncthreads();
        if (tid_ < 16 && !dry) lbase[tid_] = (int)__hip_atomic_fetch_add((unsigned*)(F.ctl + CW_CNT + 64 * tid_), (unsigned)lcnt[tid_], RLX_AGENT);
        __syncthreads();
        if (tid_ < 64 && !dry) { const int lr = tid_, m = blk * 64 + lr; const int ea = rinfo[lr * 4 + 0], eb = rinfo[lr * 4 + 1];
            const int pa = lbase[ea] + rinfo[lr * 4 + 2], pb = lbase[eb] + rinfo[lr * 4 + 3];
            F.list[ea * 16384 + pa] = m; F.list[eb * 16384 + pb] = m;
            F.toke[m * 2 + 0] = ea * 16384 + pa; F.toke[m * 2 + 1] = eb * 16384 + pb; F.tokw[m * 2 + 0] = rw[lr * 2 + 0]; F.tokw[m * 2 + 1] = rw[lr * 2 + 1]; }
        __syncthreads();
    }
}
__device__ __forceinline__ void p7_final(Frame& F, float* dst) {
    LANE_TID(F);
    LAS int* pre = (LAS int*)(F.lds + RING_OFF);
    if (tid_ == 0) { int a = 0; for (int e = 0; e < 16; ++e) { pre[e] = a * 256; a += ((int)__hip_atomic_load(F.ctl + CW_CNT + 64 * e, RLX_AGENT) + 255) >> 8; } }
    __syncthreads();
    const int gw = F.vcu * NWAVES + F.wave, NGW = F.G * NWAVES;
    const GAS f32x4* gr = (const GAS f32x4*)F.final_norm + lane_;
    f32x4 g[4];
#pragma unroll
    for (int j = 0; j < 4; ++j) g[j] = gr[64 * j];
    unsigned rt[2][4];
#define P7_LOADRT(dst, m_) do { const int mm_ = (m_) < M ? (m_) : 0; dst[0] = __hip_atomic_load((GAS unsigned*)F.toke + mm_ * 2 + 0, RLX_AGENT); dst[1] = __hip_atomic_load((GAS unsigned*)F.toke + mm_ * 2 + 1, RLX_AGENT); \
        dst[2] = __hip_atomic_load((GAS unsigned*)F.tokw + mm_ * 2 + 0, RLX_AGENT); dst[3] = __hip_atomic_load((GAS unsigned*)F.tokw + mm_ * 2 + 1, RLX_AGENT); } while (0)
    P7_LOADRT(rt[0], gw); P7_LOADRT(rt[1], gw + NGW);
    for (int m = gw; m < M; m += 2 * NGW) {
        f32x4 h[2][4]; v2u ya[2][4], yb[2][4]; float wa[2], wb[2];
#pragma unroll
        for (int u = 0; u < 2; ++u) { const int mu = m + u * NGW < M ? m + u * NGW : m;
            const int ta = (int)rt[u][0], tb = (int)rt[u][1]; wa[u] = __uint_as_float(rt[u][2]); wb[u] = __uint_as_float(rt[u][3]);
            const int sa = pre[ta >> 14] + (ta & 16383), sb = pre[tb >> 14] + (tb & 16383);
            const GAS f32x4* xr = (const GAS f32x4*)(F.out + (size_t)mu * D) + lane_;
            const GAS v2u* pa = (const GAS v2u*)(F.Y + (size_t)sa * D) + lane_; const GAS v2u* pb = (const GAS v2u*)(F.Y + (size_t)sb * D) + lane_;
#pragma unroll
            for (int j = 0; j < 4; ++j) { h[u][j] = xr[64 * j]; ya[u][j] = pa[64 * j]; yb[u][j] = pb[64 * j]; } }
        P7_LOADRT(rt[0], m + 2 * NGW); P7_LOADRT(rt[1], m + 3 * NGW);
#pragma unroll
        for (int u = 0; u < 2; ++u) { if (m + u * NGW >= M) break;
            f32x4 v[4]; float s = 0.f;
#pragma unroll
            for (int j = 0; j < 4; ++j) { const v2u a = ya[u][j], b = yb[u][j];
                v[j].x = h[u][j].x + wa[u] * bf2f((unsigned short)(a.x & 0xffff)) + wb[u] * bf2f((unsigned short)(b.x & 0xffff));
                v[j].y = h[u][j].y + wa[u] * bf2f((unsigned short)(a.x >> 16)) + wb[u] * bf2f((unsigned short)(b.x >> 16));
                v[j].z = h[u][j].z + wa[u] * bf2f((unsigned short)(a.y & 0xffff)) + wb[u] * bf2f((unsigned short)(b.y & 0xffff));
                v[j].w = h[u][j].w + wa[u] * bf2f((unsigned short)(a.y >> 16)) + wb[u] * bf2f((unsigned short)(b.y >> 16));
                s += (v[j].x * v[j].x + v[j].y * v[j].y) + (v[j].z * v[j].z + v[j].w * v[j].w); }
            const float rstd = 1.f / sqrtf(wave_sum_u(s) * (1.f / D) + EPS);
            GAS f32x4* xo = (GAS f32x4*)(dst + (size_t)(m + u * NGW) * D) + lane_;
#pragma unroll
            for (int j = 0; j < 4; ++j) xo[64 * j] = v[j] * rstd * g[j]; }
    }
#undef P7_LOADRT
}

__device__ __forceinline__ int t5_bucket(int rel) {
    const int n = rel < 0 ? -rel : rel; int b;
    if (n < 8) b = n; else if (n < 12) b = 8; else if (n < 16) b = 9; else if (n < 23) b = 10; else if (n < 32) b = 11; else if (n < 46) b = 12; else if (n < 64) b = 13; else if (n < 91) b = 14; else b = 15;
    return b + (rel > 0 ? 16 : 0);
}
#ifndef PROBE_DMA_X
#define PROBE_DMA_X 1
#endif
#ifdef PROBE_EXP2
#define PROBE_EXTRA_EXP(x) do { float d_; asm volatile("v_exp_f32 %0, %1" : "=v"(d_) : "v"(x)); } while (0)
#else
#define PROBE_EXTRA_EXP(x) do { } while (0)
#endif
namespace att {
typedef float f32x16 __attribute__((ext_vector_type(16)));
typedef short s16x4 __attribute__((ext_vector_type(4)));
typedef short v4i16_t __attribute__((ext_vector_type(4)));
typedef float f32x2_t __attribute__((ext_vector_type(2))); typedef __bf16 bf16x2_t __attribute__((ext_vector_type(2)));
__device__ __forceinline__ unsigned cvtpk(float lo, float hi) { f32x2_t v = {lo, hi}; bf16x2_t b = __builtin_convertvector(v, bf16x2_t); return __builtin_bit_cast(unsigned, b); }
__device__ __forceinline__ int crow(int r, int hi) { return (r & 3) + 8 * (r >> 2) + 4 * hi; }
__device__ __forceinline__ s16x4 vtr(const LAS unsigned char* p) { return __builtin_bit_cast(s16x4, __builtin_amdgcn_ds_read_tr16_b64_v4i16((LAS v4i16_t*)p)); }
__device__ __forceinline__ void glds16(const void* gsrc, LAS unsigned char* ldst) { __builtin_amdgcn_global_load_lds((const unsigned*)gsrc, (LAS unsigned*)ldst, 16, 0, 0); }
__device__ __forceinline__ void glds16_asm(const void* gsrc, unsigned lds_dst) { unsigned keep;
    asm volatile("s_mov_b32 %0, m0\n\ts_mov_b32 m0, %2\n\ts_nop 0\n\tglobal_load_lds_dwordx4 %1, off\n\ts_mov_b32 m0, %0" : "=&s"(keep) : "v"(gsrc), "s"(lds_dst) : "memory"); }
__device__ __forceinline__ bf16x8 pack8(const f32x16& p, int b) { v4u w; w.x = cvtpk(p[b], p[b + 1]); w.y = cvtpk(p[b + 2], p[b + 3]); w.z = cvtpk(p[b + 4], p[b + 5]); w.w = cvtpk(p[b + 6], p[b + 7]); return __builtin_bit_cast(bf16x8, w); }
__device__ __forceinline__ int opaque(int x) { asm volatile("" : "+v"(x)); return x; }
using ::lane_now;
constexpr int L_LUT = 98304, L_DN = 102400, L_SN = 102912;
constexpr float NEG = -1.0e30f;

__device__ __forceinline__ void p2_tables(Frame& F) {
    LANE_TID(F);
    LAS float* lut = (LAS float*)(F.lds + RING_OFF + L_LUT);
    for (int idx = tid_; idx < 1024; idx += NWAVES * 64) { const int h = idx >> 8, rel = (idx & 255) - 191; lut[idx] = F.rel_table[t5_bucket(rel) * 4 + h] * LOG2E; }
    if (tid_ < 128) ((LAS float*)(F.lds + RING_OFF + L_DN))[tid_] = F.diff_norm[tid_];
    if (tid_ < 64) ((LAS float*)(F.lds + RING_OFF + L_SN))[tid_] = F.sb_norm[tid_];
}

__device__ __forceinline__ void rescale_o(f32x16 (&o)[4], float al) {
#pragma unroll
    for (int d = 0; d < 4; ++d)
#pragma unroll
        for (int g = 0; g < 16; ++g) { float x = o[d][g]; asm volatile("v_mul_f32 %0, %0, %1" : "+v"(x) : "v"(al)); o[d][g] = x; }
}
struct DiffState { f32x16 o[4]; f32x16 s0, s1; bf16x8 pp[4]; float mrun, lrun; };
constexpr float DIFF_THR = 24.0f;
#define SBAR() __builtin_amdgcn_sched_barrier(0)
template <bool FAST>
__device__ __forceinline__ void diff_iter(DiffState& st, LAS unsigned char* L, const bf16x8 (&qr)[4], float cfar, int kslot  , int vslot  , int kbase, int lane_,
                                          bool do_qk, bool do_sm, bool do_pv, bool near, bool meta, const LAS float* lpu) {
    float al = 1.f, mn = st.mrun, ls = 0.f;
    int vlane, koff;
    { const int l_ = lane_now(); vlane = ((l_ >> 4) & 1) * 32 + (l_ & 3) * 8 + (4 * (l_ >> 5) + ((l_ & 15) >> 2)) * 64; koff = kbase + (l_ >> 5) * 1024 + (l_ & 31) * 16; }
    f32x16& p0 = st.s0; f32x16& p1 = st.s1;
    const LAS unsigned char* Kb = L + kslot + koff;
    SBAR();
    if (FAST || do_sm) {
        if (!FAST) {
            if (near) {
                const int ln2_ = lane_now(); const LAS float* lp = lpu - (ln2_ & 31) + 4 * (ln2_ >> 5);
#pragma unroll
                for (int g = 0; g < 16; ++g) { p0[g] += lp[(g & 3) + 8 * (g >> 2)] - cfar; p1[g] += lp[32 + (g & 3) + 8 * (g >> 2)] - cfar; }
            }
            if (meta) {
#pragma unroll
                for (int g = 0; g < 16; ++g) { if (g >= 8) p0[g] = NEG; p1[g] = NEG; }
            }
        }
        float rm = fmaxf(p0[0], p1[0]);
#pragma unroll
        for (int g = 1; g < 16; ++g) rm = fmaxf(rm, fmaxf(p0[g], p1[g]));
        rm = fmaxf(rm, __shfl_xor(rm, 32));
        mn = (rm > st.mrun + DIFF_THR || (meta && rm < st.mrun - DIFF_THR)) ? rm : st.mrun;
        al = __builtin_amdgcn_exp2f(st.mrun - mn); st.mrun = mn;
    }
#pragma unroll
    for (int k = 0; k < 4; ++k) {
        if (FAST || do_pv) {
            const LAS unsigned char* Vb = L + 49152 + vslot + vlane + k * 1024;
#pragma unroll
            for (int d = 0; d < 4; ++d) {
                const s16x4 lo = vtr(Vb + d * 4096), hi = vtr(Vb + d * 4096 + 512);
                const bf16x8 vf = (bf16x8){lo[0], lo[1], lo[2], lo[3], hi[0], hi[1], hi[2], hi[3]};
                st.o[d] = __builtin_amdgcn_mfma_f32_32x32x16_bf16(vf, st.pp[k], st.o[d], 0, 0, 0);
            }
        }
        if (FAST || do_sm) {
            f32x16& p = (k < 2) ? p0 : p1; const int b8 = (k & 1) * 8;
#pragma unroll
            for (int g = 0; g < 8; ++g) { p[b8 + g] = __builtin_amdgcn_exp2f(p[b8 + g] - mn); ls += p[b8 + g]; }
            st.pp[k] = pack8(p, b8);
            asm volatile("" : "+v"(st.pp[k]), "+v"(ls));
        }
        if (k == 2 && (FAST || do_qk)) {
            f32x16 acc = f32x16{};
#pragma unroll
            for (int d0 = 0; d0 < 4; ++d0) acc = __builtin_amdgcn_mfma_f32_32x32x16_bf16(*(const LAS bf16x8*)(Kb + d0 * 2048), qr[d0], acc, 0, 0, 0);
            p0 = acc;
        }
        SBAR();
    }
    if (FAST || do_qk) {
        f32x16 acc = f32x16{};
#pragma unroll
        for (int d0 = 0; d0 < 4; ++d0) acc = __builtin_amdgcn_mfma_f32_32x32x16_bf16(*(const LAS bf16x8*)(Kb + d0 * 2048 + 512), qr[d0], acc, 0, 0, 0);
        p1 = acc;
    }
    if (FAST || do_sm) {
        st.lrun = st.lrun * al + ls;
        if (__any(al < 1.f)) {
            rescale_o(st.o, al);
        }
    }
}
__device__ __forceinline__ float max3f(float a, float b, float c) { float r; asm("v_max3_f32 %0, %1, %2, %3" : "=v"(r) : "v"(a), "v"(b), "v"(c)); return r; }
template <bool ZREF>
__device__ __forceinline__ bool diff_iter_fast(DiffState& st, LAS unsigned char* L, const bf16x8 (&qr)[4], int kslot, int vslot, int kbase) {
    int vlane, koff;
    { const int l_ = lane_now(); vlane = ((l_ >> 4) & 1) * 32 + (l_ & 3) * 8 + (4 * (l_ >> 5) + ((l_ & 15) >> 2)) * 64; koff = kbase + (l_ >> 5) * 1024 + (l_ & 31) * 16; }
    f32x16& p0 = st.s0; f32x16& p1 = st.s1;
    const LAS unsigned char* Kb = L + kslot + koff;
    const LAS unsigned char* Vb = L + 49152 + vslot + vlane;
    s16x4 va[8]; bf16x8 kf[4];
#define VLOAD(dst, k) do { _Pragma("unroll") for (int d_ = 0; d_ < 4; ++d_) { dst[2 * d_] = vtr(Vb + (k) * 1024 + d_ * 4096); dst[2 * d_ + 1] = vtr(Vb + (k) * 1024 + d_ * 4096 + 512); } } while (0)
#define PVMMA(src, k) do { _Pragma("unroll") for (int d_ = 0; d_ < 4; ++d_) { const bf16x8 vf_ = (bf16x8){src[2 * d_][0], src[2 * d_][1], src[2 * d_][2], src[2 * d_][3], src[2 * d_ + 1][0], src[2 * d_ + 1][1], src[2 * d_ + 1][2], src[2 * d_ + 1][3]}; \
        st.o[d_] = __builtin_amdgcn_mfma_f32_32x32x16_bf16(vf_, st.pp[k], st.o[d_], 0, 0, 0); } } while (0)
#define EXPQ(p, b8, k) do { _Pragma("unroll") for (int g_ = 0; g_ < 8; ++g_) { PROBE_EXTRA_EXP(p[(b8) + g_]); p[(b8) + g_] = __builtin_amdgcn_exp2f(ZREF ? p[(b8) + g_] : p[(b8) + g_] - mn); ls += p[(b8) + g_]; } \
        if (ZREF) { pm = max3f(pm, p[(b8)], p[(b8) + 1]); pm = max3f(pm, p[(b8) + 2], p[(b8) + 3]); pm = max3f(pm, p[(b8) + 4], p[(b8) + 5]); pm = max3f(pm, p[(b8) + 6], p[(b8) + 7]); } \
        st.pp[k] = pack8(p, b8); asm volatile("" : "+v"(st.pp[k]), "+v"(ls), "+v"(pm)); } while (0)
    SBAR();
    VLOAD(va, 0);
    float mn = st.mrun, al = 1.f, pm = 0.f;
    if (!ZREF) {
        float rm;
        { float a_ = max3f(p0[0], p0[1], p1[0]), b_ = max3f(p0[2], p0[3], p1[1]); a_ = max3f(a_, p1[2], p1[3]);
#pragma unroll
          for (int g = 4; g < 16; g += 4) { a_ = max3f(a_, p0[g], p0[g + 1]); b_ = max3f(b_, p0[g + 2], p0[g + 3]); a_ = max3f(a_, p1[g], p1[g + 1]); b_ = max3f(b_, p1[g + 2], p1[g + 3]); }
          rm = max3f(a_, b_, a_); }
        rm = max3f(rm, __shfl_xor(rm, 32), rm);
        mn = (rm > st.mrun + DIFF_THR) ? rm : st.mrun;
        al = __builtin_amdgcn_exp2f(st.mrun - mn); st.mrun = mn;
    }
    float ls = 0.f;
    SBAR();
    PVMMA(va, 0); VLOAD(va, 1); EXPQ(p0, 0, 0);
    SBAR();
    PVMMA(va, 1); VLOAD(va, 2);
#pragma unroll
    for (int d0 = 0; d0 < 4; ++d0) kf[d0] = *(const LAS bf16x8*)(Kb + d0 * 2048);
    EXPQ(p0, 8, 1);
    SBAR();
    PVMMA(va, 2); VLOAD(va, 3); EXPQ(p1, 0, 2);
    { f32x16 acc = f32x16{};
#pragma unroll
      for (int d0 = 0; d0 < 4; ++d0) acc = __builtin_amdgcn_mfma_f32_32x32x16_bf16(kf[d0], qr[d0], acc, 0, 0, 0);
      p0 = acc; }
    SBAR();
#pragma unroll
    for (int d0 = 0; d0 < 4; ++d0) kf[d0] = *(const LAS bf16x8*)(Kb + d0 * 2048 + 512);
    PVMMA(va, 3); EXPQ(p1, 8, 3);
    SBAR();
    { f32x16 acc = f32x16{};
#pragma unroll
      for (int d0 = 0; d0 < 4; ++d0) acc = __builtin_amdgcn_mfma_f32_32x32x16_bf16(kf[d0], qr[d0], acc, 0, 0, 0);
      p1 = acc; }
    if (ZREF) { st.lrun += ls; return __any(pm > 16777216.f  ); }
    st.lrun = st.lrun * al + ls;
    if (__any(al < 1.f)) rescale_o(st.o, al);
    return false;
#undef VLOAD
#undef PVMMA
#undef EXPQ
}
__device__ __forceinline__ void diff_unit(Frame& F, int b, int h, int qb, float lam) {
    const int w = F.wave, s = w >> 2, wq = w & 3;
    const int r0 = qb * 128 + wq * 32, cw = r0 >> 6;
    const int N = 2 * qb + 3, Nw = cw + 2;
    LAS unsigned char* L = F.lds + RING_OFF;
    bf16x8 qr[4];
    { const int l2 = lane_now(); const bf16* qp = F.QD + (size_t)(b * T + r0) * 512 + h * 128 + s * 64 + (unsigned)((l2 & 31) * 512 + (l2 >> 5) * 8);
#pragma unroll
      for (int d0 = 0; d0 < 4; ++d0) qr[d0] = *(const bf16x8*)(qp + 16 * d0); }
    const int pk = w < 4 ? (w & 1) * 4 : (w - 4) * 4, ks = (w >> 1) & 1;
    const unsigned ldsb_ = (unsigned)(uintptr_t)L;
#define DIFF_ISSUE_K(n_, so_) do { const int t_ = (n_) - 1; const bf16* src_ = t_ < 0 ? F.KDM + (h * 2 + ks) * 4096 : F.KD + (size_t)(((b * 4 + h) * 2 + ks) * 128 + t_) * 4096; \
        const unsigned lo_ = (unsigned)lane_now() * 16u; \
        _Pragma("unroll") for (int i_ = 0; i_ < 4 * PROBE_DMA_X; ++i_) glds16_asm((const char*)(src_ + (pk + (i_ & 3)) * 512) + lo_, (unsigned)__builtin_amdgcn_readfirstlane((int)(ldsb_ + (so_) + (4 * w + (i_ & 3)) * 1024))); } while (0)
#define DIFF_ISSUE_V(n_, so_) do { const int t_ = (n_) - 1; const bf16* src_ = t_ < 0 ? F.VDM + h * 8192 : F.VD + (size_t)((b * 4 + h) * 128 + t_) * 8192; \
        const unsigned lo_ = (unsigned)lane_now() * 16u; \
        _Pragma("unroll") for (int i_ = 0; i_ < 4 * PROBE_DMA_X; ++i_) glds16_asm((const char*)(src_ + (pk + (i_ & 3)) * 512) + lo_, (unsigned)__builtin_amdgcn_readfirstlane((int)(ldsb_ + 49152 + (so_) + (4 * (w - 4) + (i_ & 3)) * 1024))); } while (0)
    DiffState st;
#pragma unroll
    for (int d = 0; d < 4; ++d) st.o[d] = f32x16{};
    st.s0 = f32x16{}; st.s1 = f32x16{}; st.mrun = 0.f; st.lrun = 0.f;
#pragma unroll
    for (int k = 0; k < 4; ++k) st.pp[k] = bf16x8{};
    const LAS float* lutb = (const LAS float*)(F.lds + RING_OFF + L_LUT) + h * 256;
    const float cfar = lutb[0];
    if (w < 4) { DIFF_ISSUE_K(0, 0); DIFF_ISSUE_K(1, 16384); DIFF_ISSUE_K(2, 32768); } else { DIFF_ISSUE_V(0, 0); }
    asm volatile("s_waitcnt vmcnt(0)" ::: "memory");
    __builtin_amdgcn_s_barrier();
    diff_iter<false>(st, L, qr, cfar, 0, 0, s * 8192, 0, true, false, false, false, false, lutb);
    int ks1 = 16384, ks3 = 0, vs_1 = 32768, vs1 = 16384;
    bool issued_prev = false;
#define DIFF_TOP(n_) do { if (issued_prev) asm volatile("s_waitcnt vmcnt(4) lgkmcnt(0)" ::: "memory"); else asm volatile("s_waitcnt vmcnt(0) lgkmcnt(0)" ::: "memory"); \
        __builtin_amdgcn_s_barrier();                                        \
        issued_prev = false; \
        if (w < 4) { if ((n_) + 3 < N) { DIFF_ISSUE_K((n_) + 3, ks3); issued_prev = true; } } else { if ((n_) + 1 < N) { DIFF_ISSUE_V((n_) + 1, vs1); issued_prev = true; } } } while (0)
#define DIFF_ADV() do { ks1 = ks1 == 32768 ? 0 : ks1 + 16384; ks3 = ks3 == 32768 ? 0 : ks3 + 16384; vs_1 = vs_1 == 32768 ? 0 : vs_1 + 16384; vs1 = vs1 == 32768 ? 0 : vs1 + 16384; } while (0)
#define DIFF_SLOW(n_) do { const int t = (n_) - 1; const int maxrel = (t < 0 ? -1 : 64 * t + 63) - r0; const int krel0 = (t < 0 ? -16 : 64 * t) - r0; \
        diff_iter<false>(st, L, qr, cfar, ks1, vs_1, s * 8192, 0, (n_) + 1 < Nw, (n_) < Nw, (n_) >= 1 && (n_) - 1 < Nw, maxrel > -91, t < 0, lutb + 191 + krel0); } while (0)
    int n = 0;
    DIFF_TOP(0); DIFF_SLOW(0); DIFF_ADV(); n = 1;
    for (bool trip = !__all(st.mrun == 0.f); n <= Nw - 4 && !trip; ++n) { DIFF_TOP(n); trip = diff_iter_fast<true>(st, L, qr, ks1, vs_1, s * 8192); DIFF_ADV(); }
    for (; n <= Nw - 4; ++n) { DIFF_TOP(n); diff_iter_fast<false>(st, L, qr, ks1, vs_1, s * 8192); DIFF_ADV(); }
    for (; n <= N; ++n) { DIFF_TOP(n); DIFF_SLOW(n); DIFF_ADV(); }
#undef DIFF_TOP
#undef DIFF_ADV
#undef DIFF_SLOW
    asm volatile("s_waitcnt vmcnt(0) lgkmcnt(0)" ::: "memory");
#undef DIFF_ISSUE_K
#undef DIFF_ISSUE_V
    const float inv = 1.f / (st.lrun + __shfl_xor(st.lrun, 32));
    LAS float* stg = (LAS float*)L;
    __syncthreads();
    const int ln_ = lane_now();
    if (s == 1) {
#pragma unroll
        for (int d = 0; d < 4; ++d)
#pragma unroll
            for (int g = 0; g < 16; ++g) stg[(d * 16 + g) * 256 + wq * 64 + ln_] = st.o[d][g] * inv;
    }
    __syncthreads();
    if (s == 0) {
        float ss = 0.f; float lam_ = lam; asm volatile("" : "+v"(lam_));
#pragma unroll
        for (int d = 0; d < 4; ++d)
#pragma unroll
            for (int g = 0; g < 16; ++g) { const float v = st.o[d][g] * inv - lam_ * stg[(d * 16 + g) * 256 + wq * 64 + ln_]; st.o[d][g] = v; ss += v * v; }
        ss += __shfl_xor(ss, 32);
        const float rn = (1.f - LAMBDA_INIT) / sqrtf(ss * (1.f / 128.f) + EPS);
        const LAS float* dn = (const LAS float*)(L + L_DN);
        const int l3 = lane_now(); bf16* op = F.MIX + (size_t)(b * T + r0) * D + h * 128 + (unsigned)((l3 & 31) * D + 4 * (l3 >> 5));
#pragma unroll
        for (int d = 0; d < 4; ++d)
#pragma unroll
            for (int g4 = 0; g4 < 4; ++g4) { const f32x4 gn = *(const LAS f32x4*)(dn + d * 32 + 8 * g4 + 4 * (l3 >> 5));
                v2u pk2_; pk2_.x = cvtpk(st.o[d][4 * g4] * rn * gn.x, st.o[d][4 * g4 + 1] * rn * gn.y); pk2_.y = cvtpk(st.o[d][4 * g4 + 2] * rn * gn.z, st.o[d][4 * g4 + 3] * rn * gn.w);
                *(v2u*)(op + d * 32 + 8 * g4) = pk2_; }
    }
    __syncthreads();
}
__device__ __forceinline__ void sb_scan_block(const f32x16& z, int kb, int t, int i, int hh, float& C, f32x16& a) {
    float x[16], lsv[16]; bool val[16];
#pragma unroll
    for (int g = 0; g < 16; ++g) {
        const int key = kb + crow(g, hh);
        val[g] = t < 0 ? key < 16 : (64 * t + key) < i;
        const float zz = z[g], e = __builtin_amdgcn_exp2f(-fabsf(zz) * LOG2E), lg = __builtin_amdgcn_logf(1.f + e) * 0.6931471805599453f;
        lsv[g] = fminf(zz, 0.f) - lg; x[g] = val[g] ? lsv[g] - zz : 0.f;
    }
    float sg[4], sp[4];
#pragma unroll
    for (int q = 0; q < 4; ++q) { sg[q] = (x[4 * q] + x[4 * q + 1]) + (x[4 * q + 2] + x[4 * q + 3]); sp[q] = __shfl_xor(sg[q], 32); }
    float above = 0.f;
#pragma unroll
    for (int q = 3; q >= 0; --q) {
        const float Tq = above + (hh == 0 ? sp[q] : 0.f);
        const float e2 = x[4 * q + 3], e1 = e2 + x[4 * q + 2], e0 = e1 + x[4 * q + 1], base = C + Tq;
        a[4 * q + 3] = val[4 * q + 3] ? __builtin_amdgcn_exp2f((lsv[4 * q + 3] + base) * LOG2E) : 0.f;
        a[4 * q + 2] = val[4 * q + 2] ? __builtin_amdgcn_exp2f((lsv[4 * q + 2] + base + e2) * LOG2E) : 0.f;
        a[4 * q + 1] = val[4 * q + 1] ? __builtin_amdgcn_exp2f((lsv[4 * q + 1] + base + e1) * LOG2E) : 0.f;
        a[4 * q + 0] = val[4 * q + 0] ? __builtin_amdgcn_exp2f((lsv[4 * q + 0] + base + e0) * LOG2E) : 0.f;
        above += sg[q] + sp[q];
    }
    C += above;
}
__device__ __forceinline__ void sb_unit(Frame& F, int b, int h, int rb) {
    const int lane = lane_now(), r = lane & 31, hh = lane >> 5, r0 = rb * 32, i = r0 + r;
    LAS unsigned char* Vst = F.lds + RING_OFF + F.wave * 8192;
    bf16x8 qr[4];
    { const int l2 = lane_now(); const bf16* qp = F.QS + (size_t)(b * T + r0) * 512 + h * 64 + (unsigned)((l2 & 31) * 512 + (l2 >> 5) * 8);
#pragma unroll
      for (int d0 = 0; d0 < 4; ++d0) qr[d0] = *(const bf16x8*)(qp + 16 * d0); }
    f32x16 o[2]; o[0] = f32x16{}; o[1] = f32x16{};
    float C = 0.f;
    const int vlane = ((lane >> 4) & 1) * 32 + (lane & 3) * 8 + (4 * hh + ((lane & 15) >> 2)) * 64;
    for (int t = r0 >> 6; t >= -1; --t) {
        const bf16* kt = t < 0 ? F.KSM + h * 4096 : F.KS + (size_t)((b * 8 + h) * 128 + t) * 4096;
        const bf16* vt = t < 0 ? F.VSM + h * 4096 : F.VS + (size_t)((b * 8 + h) * 128 + t) * 4096;
        asm volatile("s_waitcnt lgkmcnt(0)" ::: "memory");
#pragma unroll
        for (int p = 0; p < 8; ++p) glds16((const char*)(vt + p * 512) + (unsigned)lane_now() * 16u, Vst + p * 1024);
        f32x16 z0 = f32x16{}, z1 = f32x16{};
#pragma unroll
        for (int d0 = 0; d0 < 4; ++d0) {
            const unsigned ko_ = (unsigned)(opaque(hh) * 1024 + r * 16);
            const bf16x8 a0 = *(const bf16x8*)((const char*)(kt + 2 * d0 * 512) + ko_), a1 = *(const bf16x8*)((const char*)(kt + 2 * d0 * 512 + 256) + ko_);
            z0 = __builtin_amdgcn_mfma_f32_32x32x16_bf16(a0, qr[d0], z0, 0, 0, 0);
            z1 = __builtin_amdgcn_mfma_f32_32x32x16_bf16(a1, qr[d0], z1, 0, 0, 0);
        }
        f32x16 a0v, a1v;
        sb_scan_block(z1, 32, t, i, hh, C, a1v);
        sb_scan_block(z0, 0, t, i, hh, C, a0v);
        bf16x8 pa[4]; pa[0] = pack8(a0v, 0); pa[1] = pack8(a0v, 8); pa[2] = pack8(a1v, 0); pa[3] = pack8(a1v, 8);
        asm volatile("s_waitcnt vmcnt(0)" ::: "memory");
#pragma unroll
        for (int d = 0; d < 2; ++d)
#pragma unroll
            for (int k = 0; k < 4; ++k) {
                const s16x4 lo = vtr(Vst + vlane + d * 4096 + k * 1024), hi = vtr(Vst + vlane + d * 4096 + k * 1024 + 512);
                const bf16x8 vf = (bf16x8){lo[0], lo[1], lo[2], lo[3], hi[0], hi[1], hi[2], hi[3]};
                o[d] = __builtin_amdgcn_mfma_f32_32x32x16_bf16(vf, pa[k], o[d], 0, 0, 0);
            }
        if (__all(C <= -104.f)) break;
    }
    float ss = 0.f;
#pragma unroll
    for (int d = 0; d < 2; ++d)
#pragma unroll
        for (int g = 0; g < 16; ++g) ss += o[d][g] * o[d][g];
    ss += __shfl_xor(ss, 32);
    const float rn = 1.f / sqrtf(ss * (1.f / 64.f) + EPS);
    const LAS float* sn = (const LAS float*)(F.lds + RING_OFF + L_SN);
    const int l3 = lane_now(); bf16* op = F.MIX + (size_t)(b * T + r0) * D + 512 + h * 64 + (unsigned)((l3 & 31) * D + 4 * (l3 >> 5));
#pragma unroll
    for (int d = 0; d < 2; ++d)
#pragma unroll
        for (int g4 = 0; g4 < 4; ++g4) { const f32x4 gn = *(const LAS f32x4*)(sn + d * 32 + 8 * g4 + 4 * hh);
            v2u pk; pk.x = cvtpk(o[d][4 * g4] * rn * gn.x, o[d][4 * g4 + 1] * rn * gn.y); pk.y = cvtpk(o[d][4 * g4 + 2] * rn * gn.z, o[d][4 * g4 + 3] * rn * gn.w);
            *(v2u*)(op + d * 32 + 8 * g4) = pk; }
    asm volatile("s_waitcnt lgkmcnt(0)" ::: "memory");
}
__device__ __forceinline__ void p2_attention(Frame& F) {
    p2_tables(F);
    float s1 = 0.f, s2 = 0.f;
    for (int d = 0; d < 64; ++d) { s1 += F.lq1[d] * F.lk1[d]; s2 += F.lq2[d] * F.lk2[d]; }
    const float lam = __builtin_bit_cast(float, __builtin_amdgcn_readfirstlane(__builtin_bit_cast(int, __expf(s1) - __expf(s2) + LAMBDA_INIT)));
    __syncthreads();
#ifdef PROBE_SB2
    for (int u = F.vcu * NWAVES + F.wave; u < NB * 8 * 256; u += F.G * NWAVES) sb_unit(F, u >> 11, (u >> 8) & 7, u & 255);
#endif
    for (int u = F.vcu * NWAVES + F.wave; u < NB * 8 * 256; u += F.G * NWAVES) sb_unit(F, u >> 11, (u >> 8) & 7, u & 255);
    __syncthreads();
    for (int v = F.vcu; v < 256; v += F.G) { const int bh = v >> 5, p = v & 31; diff_unit(F, bh >> 2, bh & 3, p, lam); diff_unit(F, bh >> 2, bh & 3, 63 - p, lam); }
}
}

struct NaiveArgs { const bf16 *QD, *KD, *VD, *KDM, *VDM, *QS, *KS, *VS, *KSM, *VSM; bf16* MIX; const float *rel_table, *diff_norm, *sb_norm, *lq1, *lk1, *lq2, *lk2; };
__global__ void __launch_bounds__(64) naive_diff(NaiveArgs a) {
    const int blk = blockIdx.x, bh = blk >> 7, b = bh >> 2, h = bh & 3, c = blk & 127, lane = threadIdx.x, i = c * 64 + lane, row = b * T + i;
    float s1 = 0.f, s2 = 0.f;
    for (int d = 0; d < 64; ++d) { s1 += a.lq1[d] * a.lk1[d]; s2 += a.lq2[d] * a.lk2[d]; }
    const float lam = __expf(s1) - __expf(s2) + LAMBDA_INIT;
    float res[128];
#pragma unroll
    for (int d = 0; d < 128; ++d) res[d] = 0.f;
    for (int s = 0; s < 2; ++s) {
        float q[64];
        const bf16* qp = a.QD + (size_t)row * 512 + h * 128 + s * 64;
#pragma unroll
        for (int d = 0; d < 64; ++d) q[d] = bf2f(qp[d]);
        float o[128];
#pragma unroll
        for (int d = 0; d < 128; ++d) o[d] = 0.f;
        float mx = -1.0e30f, l = 0.f;
        for (int t = -1; t <= c; ++t) {
            const bf16* kt = t < 0 ? a.KDM + (h * 2 + s) * 4096 : a.KD + (size_t)(((b * 4 + h) * 2 + s) * 128 + t) * 4096;
            const bf16* vt = t < 0 ? a.VDM + h * 8192 : a.VD + (size_t)((b * 4 + h) * 128 + t) * 8192;
            const int nb = t < 0 ? 1 : 4;
            for (int kb = 0; kb < nb; ++kb) {
                float sc[16]; float bm = -1.0e30f;
#pragma unroll
                for (int kk = 0; kk < 16; ++kk) { const int key = kb * 16 + kk; float acc = 0.f;
#pragma unroll
                    for (int ch = 0; ch < 8; ++ch) { const v4u kv = *(const v4u*)(kt + ch * 512 + key * 8);
                        acc += q[ch * 8 + 0] * bf2f((unsigned short)(kv.x & 0xffff)) + q[ch * 8 + 1] * bf2f((unsigned short)(kv.x >> 16)) + q[ch * 8 + 2] * bf2f((unsigned short)(kv.y & 0xffff)) + q[ch * 8 + 3] * bf2f((unsigned short)(kv.y >> 16))
                             + q[ch * 8 + 4] * bf2f((unsigned short)(kv.z & 0xffff)) + q[ch * 8 + 5] * bf2f((unsigned short)(kv.z >> 16)) + q[ch * 8 + 6] * bf2f((unsigned short)(kv.w & 0xffff)) + q[ch * 8 + 7] * bf2f((unsigned short)(kv.w >> 16)); }
                    const int rel = t < 0 ? (key - 16 - i) : (t * 64 + key - i);
                    acc += a.rel_table[t5_bucket(rel) * 4 + h] * LOG2E;
                    sc[kk] = acc; bm = fmaxf(bm, acc); }
                const float mn = fmaxf(mx, bm), al = __builtin_amdgcn_exp2f(mx - mn); mx = mn; l *= al;
#pragma unroll
                for (int d = 0; d < 128; ++d) o[d] *= al;
#pragma unroll
                for (int kk = 0; kk < 16; ++kk) { const int key = kb * 16 + kk; const float p = __builtin_amdgcn_exp2f(sc[kk] - mn); l += p;
#pragma unroll
                    for (int db = 0; db < 4; ++db)
#pragma unroll
                        for (int q4 = 0; q4 < 4; ++q4) { const v4u vv = *(const v4u*)(vt + db * 2048 + key * 32 + q4 * 8); const int d0 = db * 32 + q4 * 8;
                            o[d0 + 0] += p * bf2f((unsigned short)(vv.x & 0xffff)); o[d0 + 1] += p * bf2f((unsigned short)(vv.x >> 16)); o[d0 + 2] += p * bf2f((unsigned short)(vv.y & 0xffff)); o[d0 + 3] += p * bf2f((unsigned short)(vv.y >> 16));
                            o[d0 + 4] += p * bf2f((unsigned short)(vv.z & 0xffff)); o[d0 + 5] += p * bf2f((unsigned short)(vv.z >> 16)); o[d0 + 6] += p * bf2f((unsigned short)(vv.w & 0xffff)); o[d0 + 7] += p * bf2f((unsigned short)(vv.w >> 16)); } }
            }
        }
        const float f = (s == 0 ? 1.f : -lam) / l;
#pragma unroll
        for (int d = 0; d < 128; ++d) res[d] += f * o[d];
    }
    float ss = 0.f;
#pragma unroll
    for (int d = 0; d < 128; ++d) ss += res[d] * res[d];
    const float r = (1.f - LAMBDA_INIT) / sqrtf(ss * (1.f / 128.f) + EPS);
    bf16* op = a.MIX + (size_t)row * D + h * 128;
#pragma unroll
    for (int d = 0; d < 128; ++d) op[d] = (bf16)f2bf(res[d] * r * a.diff_norm[d]);
}
__global__ void __launch_bounds__(64) naive_sb(NaiveArgs a) {
    const int blk = blockIdx.x, bh = blk >> 7, b = bh >> 3, h = bh & 7, c = blk & 127, lane = threadIdx.x, i = c * 64 + lane, row = b * T + i;
    float q[64], o[64];
    const bf16* qp = a.QS + (size_t)row * 512 + h * 64;
#pragma unroll
    for (int d = 0; d < 64; ++d) { q[d] = bf2f(qp[d]); o[d] = 0.f; }
    float cum = 0.f;
    for (int t = c; t >= -1; --t) {
        const bf16* kt = t < 0 ? a.KSM + h * 4096 : a.KS + (size_t)((b * 8 + h) * 128 + t) * 4096;
        const bf16* vt = t < 0 ? a.VSM + h * 4096 : a.VS + (size_t)((b * 8 + h) * 128 + t) * 4096;
        for (int key = (t < 0 ? 15 : 63); key >= 0; --key) {
            float z = 0.f;
#pragma unroll
            for (int ch = 0; ch < 8; ++ch) { const v4u kv = *(const v4u*)(kt + ch * 512 + key * 8);
                z += q[ch * 8 + 0] * bf2f((unsigned short)(kv.x & 0xffff)) + q[ch * 8 + 1] * bf2f((unsigned short)(kv.x >> 16)) + q[ch * 8 + 2] * bf2f((unsigned short)(kv.y & 0xffff)) + q[ch * 8 + 3] * bf2f((unsigned short)(kv.y >> 16))
                   + q[ch * 8 + 4] * bf2f((unsigned short)(kv.z & 0xffff)) + q[ch * 8 + 5] * bf2f((unsigned short)(kv.z >> 16)) + q[ch * 8 + 6] * bf2f((unsigned short)(kv.w & 0xffff)) + q[ch * 8 + 7] * bf2f((unsigned short)(kv.w >> 16)); }
            const bool valid = t < 0 || (t * 64 + key) < i;
            const float ls = fminf(z, 0.f) - __logf(1.f + __expf(-fabsf(z)));
            const float lk = ls - z;
            const float w = valid ? __expf(ls + cum) : 0.f;
            cum += valid ? lk : 0.f;
#pragma unroll
            for (int db = 0; db < 2; ++db)
#pragma unroll
                for (int q4 = 0; q4 < 4; ++q4) { const v4u vv = *(const v4u*)(vt + db * 2048 + key * 32 + q4 * 8); const int d0 = db * 32 + q4 * 8;
                    o[d0 + 0] += w * bf2f((unsigned short)(vv.x & 0xffff)); o[d0 + 1] += w * bf2f((unsigned short)(vv.x >> 16)); o[d0 + 2] += w * bf2f((unsigned short)(vv.y & 0xffff)); o[d0 + 3] += w * bf2f((unsigned short)(vv.y >> 16));
                    o[d0 + 4] += w * bf2f((unsigned short)(vv.z & 0xffff)); o[d0 + 5] += w * bf2f((unsigned short)(vv.z >> 16)); o[d0 + 6] += w * bf2f((unsigned short)(vv.w & 0xffff)); o[d0 + 7] += w * bf2f((unsigned short)(vv.w >> 16)); }
        }
    }
    float ss = 0.f;
#pragma unroll
    for (int d = 0; d < 64; ++d) ss += o[d] * o[d];
    const float r = 1.f / sqrtf(ss * (1.f / 64.f) + EPS);
    bf16* op = a.MIX + (size_t)row * D + 512 + h * 64;
#pragma unroll
    for (int d = 0; d < 64; ++d) op[d] = (bf16)f2bf(o[d] * r * a.sb_norm[d]);
}

#ifndef MK_REPEAT
#define MK_REPEAT 0
#endif
#define REP(k) for (int rep_ = 0; rep_ < (((MK_REPEAT) >> (k)) & 1) + 1; ++rep_)
struct Args { const float* in[19]; float* out; unsigned char* ws; int ph_lo, ph_hi; };
constexpr int NPHASE = 8;
__global__ void __launch_bounds__(NWAVES * 64, 2) fwd(Args args) {
    extern __shared__ __attribute__((aligned(16))) unsigned char lds[];
    Frame F;
    F.lds = (LAS unsigned char*)lds;
    F.MISC = (volatile LAS unsigned*)(F.lds + MISC_OFF);
    F.wave = __builtin_amdgcn_readfirstlane((int)threadIdx.x >> 6);
    F.G = gridDim.x; { const int bx = blockIdx.x; F.vcu = (F.G % 8 == 0) ? (bx % 8) * (F.G / 8) + bx / 8 : bx; }
    unsigned char* ws = args.ws;
    F.ctl = (gu32*)(ws + WS_CTL);
    F.x = args.in[0]; F.meta = args.in[1]; F.rel_table = args.in[2]; F.attn_norm = args.in[3]; F.w_in = args.in[4]; F.lq1 = args.in[5]; F.lk1 = args.in[6]; F.lq2 = args.in[7]; F.lk2 = args.in[8];
    F.diff_norm = args.in[9]; F.sb_norm = args.in[10]; F.w_out = args.in[11]; F.ffn_norm = args.in[12]; F.w_group = args.in[13]; F.w_router = args.in[14]; F.w_gate = args.in[15]; F.w_up = args.in[16];
    F.w_down = args.in[17]; F.final_norm = args.in[18]; F.out = args.out;
    F.Win_t = (bf16*)(ws + WS_WIN); F.Wout_t = (bf16*)(ws + WS_WOUT); F.Wgu_t = (bf16*)(ws + WS_WGU); F.Wd_t = (bf16*)(ws + WS_WD);
    F.HN = (bf16*)(ws + WS_HN); F.MIX = (bf16*)(ws + WS_HN); F.QD = (bf16*)(ws + WS_QD); F.KD = (bf16*)(ws + WS_KD); F.VD = (bf16*)(ws + WS_VD); F.QS = (bf16*)(ws + WS_QS); F.KS = (bf16*)(ws + WS_KS); F.VS = (bf16*)(ws + WS_VS);
    F.HN2 = (bf16*)(ws + WS_HN2); F.HID = (bf16*)(ws + WS_HID); F.Y = (bf16*)(ws + WS_Y);
    F.KDM = (bf16*)(ws + WS_META); F.VDM = F.KDM + 8 * 4096; F.KSM = F.VDM + 4 * 8192; F.VSM = F.KSM + 8 * 4096;
    F.list = (int*)(ws + WS_LIST); F.toke = (int*)(ws + WS_TOKE); F.tokw = (float*)(ws + WS_TOKW);
    for (int u = threadIdx.x; u < (LDS_BYTES - LDSCTL_OFF) / 4; u += NWAVES * 64) ((LAS unsigned*)(F.lds + LDSCTL_OFF))[u] = 0u;
    __syncthreads();
    XcdBarrier bar = xcd_barrier_post((unsigned*)(F.ctl + CW_BAR), F.MISC + 8, (int)threadIdx.x);
    const int lo = args.ph_lo, hi = args.ph_hi;
#ifndef PH_MASK
#define PH_MASK 0xFF
#endif
#define IN(k) ((((PH_MASK) >> (k)) & 1) && lo <= (k) && (k) < hi)
#define BOTH(k) (IN(k) && IN((k) + 1))
#ifdef PROBE_BAR2
#define GRID_BAR() do { xcd_barrier(bar, F.wave * 64 + lane_now()); xcd_barrier(bar, F.wave * 64 + lane_now()); } while (0)
#else
#define GRID_BAR() xcd_barrier(bar, F.wave * 64 + lane_now())
#endif
    if (IN(0)) { REP(0) p0_prologue(F); if (BOTH(0)) GRID_BAR(); }
    if (IN(1)) {
        pg8::Gemm g{F.HN, F.Win_t, M, NPROJ, D}; pg8::StaticOrder S; S.init(M, NPROJ, F.G, (int)blockIdx.x);
        pg8::EpiProj E{F.QD, F.KD, F.VD, F.QS, F.KS, F.VS, C2};
        pg8::gemm_phase<pg8::EpiProj, pg8::StaticOrder, true, true, false>(F.lds + RING_OFF, g, S, E, F.wave);
#if ((MK_REPEAT) >> 1) & 1
        pg8::gemm_phase<pg8::EpiProj, pg8::StaticOrder, true, true, false>(F.lds + RING_OFF, g, S, E, F.wave);
#endif
        if (BOTH(1)) GRID_BAR();
    }
    if (IN(2)) { REP(2) att::p2_attention(F); if (BOTH(2)) GRID_BAR(); }
    if (IN(3)) {
        pg8::Gemm g{F.MIX, F.Wout_t, M, D, D}; pg8::StaticOrder S; S.init(M, D, F.G, (int)blockIdx.x);
        pg8::EpiRes E{F.x, F.out, D};
        REP(3) pg8::gemm_phase<pg8::EpiRes, pg8::StaticOrder, true, true, false>(F.lds + RING_OFF, g, S, E, F.wave);
        if (BOTH(3)) GRID_BAR();
    }
    if (IN(4)) {
#ifdef PROBE_P4X2
        p4_route(F, true); __syncthreads();
#endif
        p4_route(F); if (BOTH(4)) GRID_BAR(); }
    if (IN(5)) {
        pg8::Gemm g{F.HN2, F.Wgu_t, M, 1024, D}; pg8::GroupedOrder S; S.init((const unsigned*)(F.ctl + CW_CNT), F.list, F.G, (int)blockIdx.x);
        pg8::EpiSwiGLU E{F.HID};
        pg8::gemm_phase<pg8::EpiSwiGLU, pg8::GroupedOrder, true, true, true>(F.lds + RING_OFF, g, S, E, F.wave);
#if ((MK_REPEAT) >> 5) & 1
        pg8::gemm_phase<pg8::EpiSwiGLU, pg8::GroupedOrder, true, true, true>(F.lds + RING_OFF, g, S, E, F.wave);
#endif
        if (BOTH(5)) GRID_BAR();
    }
    if (IN(6)) {
        pg8::Gemm g{F.HID, F.Wd_t, SLOT_ROWS, 1024, DEXP}; pg8::GroupedOrder S; S.init((const unsigned*)(F.ctl + CW_CNT), F.list, F.G, (int)blockIdx.x);
        pg8::EpiY E{F.Y};
        pg8::gemm_phase<pg8::EpiY, pg8::GroupedOrder, true, true, false>(F.lds + RING_OFF, g, S, E, F.wave);
#if ((MK_REPEAT) >> 6) & 1
        pg8::gemm_phase<pg8::EpiY, pg8::GroupedOrder, true, true, false>(F.lds + RING_OFF, g, S, E, F.wave);
#endif
        if (BOTH(6)) GRID_BAR();
    }
#ifdef PROBE_P7X2
    if (IN(7)) { float* keep_ = F.out; p7_final(F, (float*)(F.HN)); F.out = keep_; }
#endif
    if (IN(7)) p7_final(F, F.out);
#undef IN
#undef BOTH
#undef GRID_BAR
}

#ifndef MK_STAGED
#define MK_STAGED 0
#endif
#ifndef MK_NAIVE
#define MK_NAIVE 0
#endif
extern "C" void kernel_launch(void* const* d_in, const int* in_sizes, int n_in, void* d_out, int out_size, void* d_ws, size_t ws_size, hipStream_t stream) {
    static int grid = 0;
    if (grid == 0) {
        if (n_in != 19 || out_size != M * D || ws_size < WS_END) { fprintf(stderr, "kernel_launch: unexpected shapes (n_in %d, out %d, ws %zu); nothing launched\n", n_in, out_size, ws_size); grid = -1; return; }
        int dev = 0, cus = 0, per_cu = 0;
        if (hipGetDevice(&dev) != hipSuccess || hipDeviceGetAttribute(&cus, hipDeviceAttributeMultiprocessorCount, dev) != hipSuccess) { grid = -1; return; }
        if (hipFuncSetAttribute((const void*)fwd, hipFuncAttributeMaxDynamicSharedMemorySize, LDS_BYTES) != hipSuccess) { fprintf(stderr, "kernel_launch: hipFuncSetAttribute failed\n"); grid = -1; return; }
        if (hipOccupancyMaxActiveBlocksPerMultiprocessor(&per_cu, (const void*)fwd, NWAVES * 64, LDS_BYTES) != hipSuccess || per_cu < 1) fprintf(stderr, "kernel_launch: occupancy query says %d per CU\n", per_cu);
        (void)hipGetLastError();
        grid = cus;
    }
    if (grid < 0) return;
    (void)hipMemsetAsync((char*)d_ws + WS_CTL, 0, CTL_ZERO_BYTES, stream);
    Args a{};
    for (int i = 0; i < 19; ++i) a.in[i] = (const float*)d_in[i];
    a.out = (float*)d_out; a.ws = (unsigned char*)d_ws;
#if MK_STAGED
    unsigned char* ws = (unsigned char*)d_ws;
    NaiveArgs na{};
    na.QD = (const bf16*)(ws + WS_QD); na.KD = (const bf16*)(ws + WS_KD); na.VD = (const bf16*)(ws + WS_VD); na.QS = (const bf16*)(ws + WS_QS); na.KS = (const bf16*)(ws + WS_KS); na.VS = (const bf16*)(ws + WS_VS);
    na.KDM = (const bf16*)(ws + WS_META); na.VDM = na.KDM + 8 * 4096; na.KSM = na.VDM + 4 * 8192; na.VSM = na.KSM + 8 * 4096; na.MIX = (bf16*)(ws + WS_HN);
    na.rel_table = (const float*)d_in[2]; na.diff_norm = (const float*)d_in[9]; na.sb_norm = (const float*)d_in[10]; na.lq1 = (const float*)d_in[5]; na.lk1 = (const float*)d_in[6]; na.lq2 = (const float*)d_in[7]; na.lk2 = (const float*)d_in[8];
    for (int ph = 0; ph < NPHASE; ++ph) {
        if (MK_NAIVE && ph == 2) { hipLaunchKernelGGL(naive_diff, dim3(NB * 4 * 128), dim3(64), 0, stream, na); hipLaunchKernelGGL(naive_sb, dim3(NB * 8 * 128), dim3(64), 0, stream, na); continue; }
        a.ph_lo = ph; a.ph_hi = ph + 1;
        hipLaunchKernelGGL(fwd, dim3(grid), dim3(NWAVES * 64), LDS_BYTES, stream, a);
    }
#else
    a.ph_lo = 0; a.ph_hi = NPHASE;
    hipLaunchKernelGGL(fwd, dim3(grid), dim3(NWAVES * 64), LDS_BYTES, stream, a);
#endif
    const hipError_t le = hipPeekAtLastError();
    if (le != hipSuccess) fprintf(stderr, "kernel_launch: launch failed: %s\n", hipGetErrorName(le));
}
```
